# Optimizing an MI355X kernel written in HIP

```python
import math
import jax
import jax.numpy as jnp
from jax import lax
import numpy as np

D_MODEL = 2048
BATCH = 8
SEQ = 2048
DEPTH = 2

GRID_W = 64
Q_BLOCK = 128
NORM_EPS = 1e-6

A_HEADS = 8
A_KV_HEADS = 2
A_HEAD_DIM = 128
A_WIDTH = A_HEADS * A_HEAD_DIM
ROPE_THETA = 10000.0

B_WIDTH = 512
B_EMB_DIM = 33
B_FILTER_HIDDEN = 64
B_DECAY_TARGET = 1e-2
B_FAST_DECAY_PCT = 0.3
B_SLOW_DECAY_PCT = 1.5

C_HEADS = 8
C_HEAD_DIM = 64
C_WIDTH = C_HEADS * C_HEAD_DIM
C_DECAY_LORA = 96
C_AAA_LORA = 96
C_GATE_LORA = 256
C_SHIFT = 3 * C_WIDTH + C_DECAY_LORA + C_AAA_LORA
C_GN_EPS = 64e-5

D_HEADS = 4
D_HEAD_DIM = 64
D_V_DIM = 2 * D_HEAD_DIM
D_WIDTH = D_HEADS * D_V_DIM

N_BRANCHES = 4
BRANCH_WIDTHS = (A_WIDTH, B_WIDTH, C_WIDTH, D_WIDTH)
D_MIX = A_WIDTH + B_WIDTH + C_WIDTH + D_WIDTH
IN_SPLITS = (A_WIDTH, A_KV_HEADS * A_HEAD_DIM, A_KV_HEADS * A_HEAD_DIM, 3 * B_WIDTH, C_SHIFT, C_GATE_LORA, 2 * D_HEADS * D_HEAD_DIM, 2 * D_HEADS * D_HEAD_DIM, D_WIDTH)
D_IN = sum(IN_SPLITS)
FFN_HIDDEN = -(-8 * D_MODEL // (3 * 256)) * 256

kernel_name = 'hybrid_gated_parallel_encoder'


def _offsets(sizes):
    return [int(v) for v in np.cumsum(sizes)[:-1]]


def rms_norm(x, g):
    xf = x.astype(jnp.float32)
    y = xf * lax.rsqrt(jnp.mean(xf * xf, axis=-1, keepdims=True) + NORM_EPS)
    return (y * g.astype(jnp.float32)).astype(x.dtype)


def axial_rope_tables(L):
    rows = L // GRID_W
    row_idx = jnp.repeat(jnp.arange(rows, dtype=jnp.float32), GRID_W)
    col_idx = jnp.tile(jnp.arange(GRID_W, dtype=jnp.float32), rows)
    axis_dim = A_HEAD_DIM // 2
    inv_freq = ROPE_THETA ** (-jnp.arange(0, axis_dim, 2, dtype=jnp.float32) / axis_dim)
    ang_r = row_idx[:, None] * inv_freq[None, :]
    ang_c = col_idx[:, None] * inv_freq[None, :]
    ang = jnp.concatenate([ang_r, ang_r, ang_c, ang_c], axis=-1)
    return jnp.cos(ang), jnp.sin(ang)


def apply_axial_rope(x, cos, sin):
    xr = x.reshape(x.shape[:-1] + (2, 2, A_HEAD_DIM // 4))
    rot = jnp.stack([-xr[..., 1, :], xr[..., 0, :]], axis=-2).reshape(x.shape)
    return x * cos[:, None, :] + rot * sin[:, None, :]


def gqa_axial_attention(q, k, v, q_norm, k_norm, cos, sin):
    B, T = q.shape[:2]
    G = A_HEADS // A_KV_HEADS
    nb = T // Q_BLOCK
    q = apply_axial_rope(rms_norm(q.reshape(B, T, A_HEADS, A_HEAD_DIM), q_norm), cos, sin)
    k = apply_axial_rope(rms_norm(k.reshape(B, T, A_KV_HEADS, A_HEAD_DIM), k_norm), cos, sin)
    v = v.reshape(B, T, A_KV_HEADS, A_HEAD_DIM)
    scale = A_HEAD_DIM ** -0.5
    q_blocks = q.reshape(B, nb, Q_BLOCK, A_KV_HEADS, G, A_HEAD_DIM).transpose(1, 0, 3, 4, 2, 5)

    def block(qb):
        s = jnp.einsum('bhgqd,bkhd->bhgqk', qb, k).astype(jnp.float32) * scale
        p = jax.nn.softmax(s, axis=-1).astype(v.dtype)
        return jnp.einsum('bhgqk,bkhd->bhgqd', p, v)

    o = lax.map(block, q_blocks)
    return o.transpose(1, 0, 4, 2, 3, 5).reshape(B, T, A_WIDTH)


def hyena_two_sided_filter(L, w1, b1, w2, b2, w3, b3, w4, freq):
    f32 = jnp.float32
    w1, b1, w2, b2, w3, b3, w4, freq = (a.astype(f32) for a in (w1, b1, w2, b2, w3, b3, w4, freq))
    t = jnp.linspace(0.0, 1.0, L, dtype=f32)[:, None]
    n_bands = (B_EMB_DIM - 1) // 2
    bands = jnp.linspace(1e-4, n_bands - 1, n_bands, dtype=f32)[None, :]
    ang = (2.0 * math.pi / L) * jnp.arange(L, dtype=f32)[:, None] * bands
    z = jnp.concatenate([t, jnp.cos(ang), -jnp.sin(ang)], axis=-1)
    hid = jnp.sin(freq * (z @ w1 + b1))
    hid = jnp.sin(freq * (hid @ w2 + b2))
    hid = jnp.sin(freq * (hid @ w3 + b3))
    h = hid @ w4
    max_decay = math.log(B_DECAY_TARGET) / B_FAST_DECAY_PCT
    min_decay = math.log(B_DECAY_TARGET) / B_SLOW_DECAY_PCT
    deltas = jnp.abs(jnp.linspace(min_decay, max_decay, B_WIDTH, dtype=f32))
    window = jnp.exp(-t * deltas[None, :])
    h_fwd = h[:, :B_WIDTH] * window
    h_bwd = h[:, B_WIDTH:] * window
    kbuf = jnp.concatenate([h_fwd, jnp.zeros((1, B_WIDTH), f32), h_bwd[1:][::-1]], axis=0)
    return kbuf / jnp.sum(jnp.abs(kbuf), axis=0, keepdims=True)


def hyena_mixer(u, conv_w, conv_b, w1, b1, w2, b2, w3, b3, w4, freq, skip):
    B, T = u.shape[:2]
    up = jnp.pad(u, ((0, 0), (1, 1), (0, 0)))
    uc = conv_w[0] * up[:, :-2] + conv_w[1] * up[:, 1:-1] + conv_w[2] * up[:, 2:] + conv_b
    v, x1, x0 = jnp.split(uc, 3, axis=-1)
    z = (v * x1).astype(jnp.float32)
    kbuf = hyena_two_sided_filter(T, w1, b1, w2, b2, w3, b3, w4, freq)
    n_fft = 2 * T
    zf = jnp.fft.rfft(z, n=n_fft, axis=1)
    kf = jnp.fft.rfft(kbuf, n=n_fft, axis=0)
    y = jnp.fft.irfft(zf * kf[None], n=n_fft, axis=1)[:, :T]
    y = y + z * skip.astype(jnp.float32)
    return y.astype(u.dtype) * x0


def rwkv7_scan(r, w, k, v, a_vec, b_vec, reverse):
    B, T, H, N = r.shape

    def step(S, inp):
        r_t, w_t, k_t, v_t, a_t, b_t = inp
        sa = jnp.einsum('bhvk,bhk->bhv', S, a_t)
        S = S * w_t[:, :, None, :] + sa[..., None] * b_t[:, :, None, :] + v_t[..., None] * k_t[:, :, None, :]
        return S, jnp.einsum('bhvk,bhk->bhv', S, r_t)

    xs = tuple(jnp.moveaxis(a, 1, 0) for a in (r, w, k, v, a_vec, b_vec))
    S0 = jnp.zeros((B, H, N, N), jnp.float32)
    _, o = lax.scan(step, S0, xs, reverse=reverse)
    return jnp.moveaxis(o, 0, 1)


def rwkv7_mixer(feats, g_lo, mu, w0, w_up, a0, a_up, g_up, k_k, k_a, r_k, ln_w, ln_b):
    f32 = jnp.float32
    B, T = feats.shape[:2]
    prev = jnp.pad(feats, ((0, 0), (1, 0), (0, 0)))[:, :-1]
    nxt = jnp.pad(feats, ((0, 0), (0, 1), (0, 0)))[:, 1:]
    g = jax.nn.sigmoid(g_lo) @ g_up
    split_at = [C_WIDTH, 2 * C_WIDTH, 3 * C_WIDTH, 3 * C_WIDTH + C_DECAY_LORA]
    heads = lambda a: a.reshape(B, T, C_HEADS, C_HEAD_DIM).astype(f32)
    ln_w_h = ln_w.reshape(C_HEADS, C_HEAD_DIM).astype(f32)
    ln_b_h = ln_b.reshape(C_HEADS, C_HEAD_DIM).astype(f32)
    r_k_h = r_k.astype(f32)
    outs = []
    for d, shifted in enumerate((prev, nxt)):
        f = feats + (shifted - feats) * mu[d]
        r, k, v, w_lo, a_lo = jnp.split(f, split_at, axis=-1)
        w = -jax.nn.softplus(-(w0[d] + jnp.tanh(w_lo) @ w_up[d])) - 0.5
        decay = jnp.exp(-jnp.exp(w.astype(f32)))
        a = jax.nn.sigmoid(a0[d] + a_lo @ a_up[d])
        kk = heads(k * k_k)
        kk = kk / jnp.maximum(jnp.sqrt(jnp.sum(kk * kk, axis=-1, keepdims=True)), 1e-12)
        k = k * (1.0 + (a - 1.0) * k_a)
        r_h, k_h, v_h, a_h, w_h = heads(r), heads(k), heads(v), heads(a), heads(decay)
        o = rwkv7_scan(r_h, w_h, k_h, v_h, -kk, kk * a_h, reverse=(d == 1))
        mean = jnp.mean(o, axis=-1, keepdims=True)
        var = jnp.mean(jnp.square(o - mean), axis=-1, keepdims=True)
        o = (o - mean) * lax.rsqrt(var + C_GN_EPS) * ln_w_h + ln_b_h
        o = o + jnp.sum(r_h * k_h * r_k_h, axis=-1, keepdims=True) * v_h
        outs.append(o)
    y = (outs[0] + outs[1]).reshape(B, T, C_WIDTH)
    return y.astype(g.dtype) * g


def diff_attention(q, k, v, lq1, lk1, lq2, lk2, subln, lam_init):
    f32 = jnp.float32
    B, T = q.shape[:2]
    nb = T // Q_BLOCK
    q = q.reshape(B, T, D_HEADS, 2, D_HEAD_DIM)
    k = k.reshape(B, T, D_HEADS, 2, D_HEAD_DIM)
    v = v.reshape(B, T, D_HEADS, D_V_DIM)
    lam = (jnp.exp(jnp.sum(lq1.astype(f32) * lk1.astype(f32))) - jnp.exp(jnp.sum(lq2.astype(f32) * lk2.astype(f32))) + lam_init)
    slopes = 2.0 ** (-8.0 * jnp.arange(1, D_HEADS + 1, dtype=f32) / D_HEADS)
    scale = D_HEAD_DIM ** -0.5
    q_blocks = q.reshape(B, nb, Q_BLOCK, D_HEADS, 2, D_HEAD_DIM).transpose(1, 0, 2, 3, 4, 5)
    q_pos = jnp.arange(T).reshape(nb, Q_BLOCK)
    k_pos = jnp.arange(T)

    def block(args):
        qb, qp = args
        s = jnp.einsum('bqhcd,bkhcd->bhcqk', qb, k).astype(f32) * scale
        dist = jnp.abs(qp[:, None] - k_pos[None, :]).astype(f32)
        s = s - slopes[:, None, None, None] * dist
        p = jax.nn.softmax(s, axis=-1)
        attn = p[:, :, 0] - lam * p[:, :, 1]
        return jnp.einsum('bhqk,bkhe->bqhe', attn.astype(v.dtype), v)

    o = lax.map(block, (q_blocks, q_pos))
    o = o.transpose(1, 0, 2, 3, 4).reshape(B, T, D_HEADS, D_V_DIM)
    o = rms_norm(o, subln) * (1.0 - lam_init)
    return o.reshape(B, T, D_WIDTH)


def setup_inputs(seed: int = 0) -> dict:
    key = jax.random.key(seed)
    keys = iter(jax.random.split(key, 48))
    f32 = jnp.float32

    def nrm(shape, scale):
        return scale * jax.random.normal(next(keys), shape, f32)

    def gain(shape):
        return 1.0 + nrm(shape, 0.02)

    br_scale = jnp.concatenate([jnp.full((w,), w ** -0.5, f32) for w in BRANCH_WIDTHS])
    return {
        'x': nrm((BATCH, SEQ, D_MODEL), 1.0),
        'norm_mix': gain((DEPTH, D_MODEL)),
        'w_in': nrm((DEPTH, D_MODEL, D_IN), D_MODEL ** -0.5),
        'a_q_norm': gain((DEPTH, A_HEAD_DIM)),
        'a_k_norm': gain((DEPTH, A_HEAD_DIM)),
        'b_conv_w': nrm((DEPTH, 3, 3 * B_WIDTH), 0.5),
        'b_conv_b': nrm((DEPTH, 3 * B_WIDTH), 0.02),
        'b_filt_w1': nrm((DEPTH, B_EMB_DIM, B_FILTER_HIDDEN), B_EMB_DIM ** -0.5),
        'b_filt_b1': nrm((DEPTH, B_FILTER_HIDDEN), 0.02),
        'b_filt_w2': nrm((DEPTH, B_FILTER_HIDDEN, B_FILTER_HIDDEN), B_FILTER_HIDDEN ** -0.5),
        'b_filt_b2': nrm((DEPTH, B_FILTER_HIDDEN), 0.02),
        'b_filt_w3': nrm((DEPTH, B_FILTER_HIDDEN, B_FILTER_HIDDEN), B_FILTER_HIDDEN ** -0.5),
        'b_filt_b3': nrm((DEPTH, B_FILTER_HIDDEN), 0.02),
        'b_filt_w4': nrm((DEPTH, B_FILTER_HIDDEN, 2 * B_WIDTH), B_FILTER_HIDDEN ** -0.5),
        'b_filt_freq': gain((DEPTH, B_FILTER_HIDDEN)),
        'b_skip': nrm((DEPTH, B_WIDTH), 0.5),
        'c_mu': jax.random.uniform(next(keys), (DEPTH, 2, C_SHIFT), f32),
        'c_w0': jnp.linspace(-6.0, -1.0, C_WIDTH, dtype=f32) + nrm((DEPTH, 2, C_WIDTH), 0.1),
        'c_w_up': nrm((DEPTH, 2, C_DECAY_LORA, C_WIDTH), 0.1 * C_DECAY_LORA ** -0.5),
        'c_a0': nrm((DEPTH, 2, C_WIDTH), 0.1),
        'c_a_up': nrm((DEPTH, 2, C_AAA_LORA, C_WIDTH), C_AAA_LORA ** -0.5),
        'c_g_up': nrm((DEPTH, C_GATE_LORA, C_WIDTH), C_GATE_LORA ** -0.5),
        'c_k_k': 0.85 + nrm((DEPTH, C_WIDTH), 0.02),
        'c_k_a': gain((DEPTH, C_WIDTH)),
        'c_r_k': nrm((DEPTH, C_HEADS, C_HEAD_DIM), 0.1),
        'c_ln_w': gain((DEPTH, C_WIDTH)),
        'c_ln_b': nrm((DEPTH, C_WIDTH), 0.02),
        'd_lq1': nrm((DEPTH, D_HEAD_DIM), 0.1),
        'd_lk1': nrm((DEPTH, D_HEAD_DIM), 0.1),
        'd_lq2': nrm((DEPTH, D_HEAD_DIM), 0.1),
        'd_lk2': nrm((DEPTH, D_HEAD_DIM), 0.1),
        'd_subln': gain((DEPTH, D_V_DIM)),
        'w_gate': nrm((DEPTH, N_BRANCHES, D_MODEL, D_MODEL), D_MODEL ** -0.5),
        'w_branch': nrm((DEPTH, D_MIX, D_MODEL), 1.0) * br_scale[None, :, None],
        'w_out': nrm((DEPTH, D_MODEL, D_MODEL), D_MODEL ** -0.5),
        'norm_ffn': gain((DEPTH, D_MODEL)),
        'w_ff_gate': nrm((DEPTH, D_MODEL, FFN_HIDDEN), D_MODEL ** -0.5),
        'w_ff_up': nrm((DEPTH, D_MODEL, FFN_HIDDEN), D_MODEL ** -0.5),
        'w_ff_down': nrm((DEPTH, FFN_HIDDEN, D_MODEL), FFN_HIDDEN ** -0.5),
        'norm_final': gain((D_MODEL,)),
    }


def reference(x, norm_mix, w_in, a_q_norm, a_k_norm, b_conv_w, b_conv_b, b_filt_w1, b_filt_b1, b_filt_w2, b_filt_b2, b_filt_w3, b_filt_b3, b_filt_w4, b_filt_freq, b_skip, c_mu, c_w0, c_w_up, c_a0, c_a_up, c_g_up, c_k_k, c_k_a, c_r_k, c_ln_w, c_ln_b, d_lq1, d_lk1, d_lq2, d_lk2, d_subln, w_gate, w_branch, w_out, norm_ffn, w_ff_gate, w_ff_up, w_ff_down, norm_final):
    L = x.shape[1]
    cos, sin = axial_rope_tables(L)
    in_off = _offsets(IN_SPLITS)
    br_off = _offsets(BRANCH_WIDTHS)
    for l in range(DEPTH):
        h = rms_norm(x, norm_mix[l])
        aq, ak, av, bu, cf, cg, dq, dk, dv = jnp.split(h @ w_in[l], in_off, axis=-1)
        o_a = gqa_axial_attention(aq, ak, av, a_q_norm[l], a_k_norm[l], cos, sin)
        o_b = hyena_mixer(bu, b_conv_w[l], b_conv_b[l], b_filt_w1[l], b_filt_b1[l], b_filt_w2[l], b_filt_b2[l], b_filt_w3[l], b_filt_b3[l], b_filt_w4[l], b_filt_freq[l], b_skip[l])
        o_c = rwkv7_mixer(cf, cg, c_mu[l], c_w0[l], c_w_up[l], c_a0[l], c_a_up[l], c_g_up[l], c_k_k[l], c_k_a[l], c_r_k[l], c_ln_w[l], c_ln_b[l])
        lam_init = 0.8 - 0.6 * math.exp(-0.3 * l)
        o_d = diff_attention(dq, dk, dv, d_lq1[l], d_lk1[l], d_lq2[l], d_lk2[l], d_subln[l], lam_init)
        branches = (o_a, o_b, o_c, o_d)
        w_br = jnp.split(w_branch[l], br_off, axis=0)
        merged = jax.nn.sigmoid(h @ w_gate[l, 0]) * (branches[0] @ w_br[0])
        for i in range(1, N_BRANCHES):
            merged = merged + jax.nn.sigmoid(h @ w_gate[l, i]) * (branches[i] @ w_br[i])
        x = x + merged @ w_out[l]
        h2 = rms_norm(x, norm_ffn[l])
        x = x + (jax.nn.silu(h2 @ w_ff_gate[l]) * (h2 @ w_ff_up[l])) @ w_ff_down[l]
    return rms_norm(x, norm_final)
```

```cpp
#ifndef PG8_V2
#define PG8_V2 1
#endif
#ifndef PG8_SP2
#define PG8_SP2 true
#endif
#include <hip/hip_runtime.h>
#include <hip/hip_cooperative_groups.h>
#include <cstdio>
#include <cstdint>
namespace cg = cooperative_groups;
namespace pg8 {
#define PG8_LAS __attribute__((address_space(3)))
typedef unsigned short bf16_t;
typedef short bf16x8 __attribute__((ext_vector_type(8)));
typedef float f32x4 __attribute__((ext_vector_type(4)));
typedef unsigned u32x4 __attribute__((ext_vector_type(4)));
constexpr int BM = 256, BK = 64, HALF = 128, HTB = HALF * BK * 2  , STAGE_BYTES = 8 * HTB, NXCD = 8, WGM = 8;

__host__ __device__ __forceinline__ int lds_byte(int r, int c) { const int st = (r >> 4) * 2 + (c >> 5), rr = r & 15, cc = c & 31, ob = rr * 64 + cc * 2; return st * 1024 + (ob ^ (((ob >> 9) & 1) << 5)); }
__host__ __device__ __forceinline__ void stage_rc(int b, int& R, int& C) { const int st = b / 1024, sb = b % 1024, swz = sb ^ (((sb >> 9) & 1) << 5); R = (st >> 1) * 16 + swz / 64; C = (st & 1) * 32 + (swz % 64) / 2; }
__host__ __device__ __forceinline__ int perm32(int rho) { const int n = rho >> 4, i = rho & 15; return 8 * (i >> 2) + 4 * n + (i & 3); }

struct Unit { int pm, pn; };
struct Gemm { const bf16_t* A; const bf16_t* Bt; int M, N, K; };

struct StaticOrder {
    int nM, nN, nwg, G, c;
    __host__ __device__ void init(int M, int N, int G_, int c_) { nM = M / BM; nN = N / BM; nwg = nM * nN; G = G_; c = c_; }
    __host__ __device__ bool next(int i, Unit& u) const {
        const long L = (long)i * G + c; if (L >= nwg) return false;
        int wgid = (int)L; { const int q = nwg / NXCD, r = nwg % NXCD, xcd = wgid % NXCD, off = wgid / NXCD; wgid = (xcd < r ? xcd * (q + 1) : r * (q + 1) + (xcd - r) * q) + off; }
        const int nig = WGM * nN, gid = wgid / nig, fm = gid * WGM, gsz = (nM - fm) < WGM ? (nM - fm) : WGM;
        u.pm = fm + ((wgid % nig) % gsz); u.pn = (wgid % nig) / gsz; return true;
    }
    __device__ __forceinline__ void a_ready(const Unit&) const {}
    __device__ __forceinline__ void done(const Unit&) const {}
};
__device__ __forceinline__ unsigned cvt_pk_bf16(float lo, float hi) { unsigned r; asm volatile("v_cvt_pk_bf16_f32 %0, %1, %2" : "=v"(r) : "v"(lo), "v"(hi)); return r; }
typedef float f32x2 __attribute__((ext_vector_type(2)));
template <class Epi, class Sched, bool ALIGN_EPI = false, bool SP2 = false>
__device__ __forceinline__ void gemm_phase(PG8_LAS unsigned char* lds, const Gemm g, const Sched& S, const Epi& E) {
    int tid = threadIdx.x; asm volatile("" : "+v"(tid));
    const int wid = __builtin_amdgcn_readfirstlane(tid >> 6), lane = tid & 63, wr = wid >> 2, wc = wid & 3, fr = lane & 15, fq = lane >> 4;
    const int K = g.K, nt = K / BK;
    unsigned voffA[2], voffB[2];
#pragma unroll
    for (int i = 0; i < 2; ++i) { int R, C; stage_rc(tid * 16 + i * 8192, R, C); const int Rb = Epi::PERM ? ((R & ~31) + perm32(R & 31)) : R;
        voffA[i] = (unsigned)(R * K + C) * 2u; voffB[i] = (unsigned)(Rb * K + C) * 2u; }
    const size_t kstep = (size_t)(BK * 2);
    const size_t hstep = (size_t)HALF * K * 2;
    const size_t tstep = 2 * hstep;
    const unsigned ldsw = (unsigned)wid * 1024u;
    const int aoff = lds_byte(wr * 64 + fr, fq * 8), boff = lds_byte(wc * 32 + fr, fq * 8);
#define PG8_SA(b, h) (((b) * 2 + (h)) * HTB)
#define PG8_SB(b, h) ((4 + (b) * 2 + (h)) * HTB)
#define PG8_STAGE(bufoff, gbase, voff) do { _Pragma("unroll") for (int _i = 0; _i < 2; ++_i) \
        __builtin_amdgcn_global_load_lds((const unsigned*)((const char*)(gbase) + (voff)[_i]), (PG8_LAS unsigned*)(lds + (bufoff) + ldsw + _i * 8192), 16, 0, 0); } while (0)
#define PG8_LDA(dst, b, h) do { _Pragma("unroll") for (int m = 0; m < 4; ++m) _Pragma("unroll") for (int k = 0; k < 2; ++k) dst[m][k] = *(const PG8_LAS bf16x8*)(lds + PG8_SA(b, h) + aoff + m * 2048 + k * 1024); } while (0)
#define PG8_LDB(dst, b, h) do { _Pragma("unroll") for (int n = 0; n < 2; ++n) _Pragma("unroll") for (int k = 0; k < 2; ++k) dst[n][k] = *(const PG8_LAS bf16x8*)(lds + PG8_SB(b, h) + boff + n * 2048 + k * 1024); } while (0)
#define PG8_MMA(ai, bj, At, Bt) do { __builtin_amdgcn_s_setprio(1); _Pragma("unroll") for (int m = 0; m < 4; ++m) _Pragma("unroll") for (int n = 0; n < 2; ++n) _Pragma("unroll") for (int k = 0; k < 2; ++k) \
        acc[ai][bj][m][n] = __builtin_amdgcn_mfma_f32_16x16x32_bf16(Bt[n][k], At[m][k], acc[ai][bj][m][n], 0, 0, 0); __builtin_amdgcn_s_setprio(0); } while (0)
#define PG8_WAIT_V(n) asm volatile("s_waitcnt vmcnt(" #n ")" ::: "memory")
#define PG8_WAIT_L(n) asm volatile("s_waitcnt lgkmcnt(" #n ")" ::: "memory")
#define PG8_BAR __builtin_amdgcn_s_barrier()
#define PG8_SCHED __builtin_amdgcn_sched_barrier(0)
    Unit cur, nxt; int ui = 0;
    if (!S.next(0, cur)) return;
    f32x4 acc[2][2][4][2];
#pragma unroll
    for (int a = 0; a < 2; ++a)
#pragma unroll
        for (int b = 0; b < 2; ++b)
#pragma unroll
            for (int m = 0; m < 4; ++m)
#pragma unroll
                for (int n = 0; n < 2; ++n) acc[a][b][m][n] = (f32x4){0.f, 0.f, 0.f, 0.f};
    bf16x8 At[4][2], B0[2][2], B1[2][2];
    const char* cA = (const char*)g.A + (size_t)cur.pm * tstep; const char* cB = (const char*)g.Bt + (size_t)cur.pn * tstep;
    S.a_ready(cur);
    if constexpr (SP2) {
        PG8_STAGE(PG8_SB(0, 0), cB, voffB); PG8_STAGE(PG8_SB(0, 1), cB + hstep, voffB); PG8_STAGE(PG8_SA(0, 0), cA, voffA); PG8_STAGE(PG8_SA(0, 1), cA + hstep, voffA);
        if (wr == 1) PG8_BAR;
        PG8_WAIT_V(2); PG8_BAR;
        PG8_STAGE(PG8_SB(1, 0), cB + kstep, voffB); PG8_STAGE(PG8_SA(1, 0), cA + kstep, voffA); PG8_STAGE(PG8_SB(1, 1), cB + hstep + kstep, voffB);
        PG8_WAIT_V(6); PG8_BAR;
    } else {
        PG8_STAGE(PG8_SB(0, 0), cB, voffB); PG8_STAGE(PG8_SA(0, 0), cA, voffA); PG8_STAGE(PG8_SB(0, 1), cB + hstep, voffB); PG8_STAGE(PG8_SA(0, 1), cA + hstep, voffA);
        if (wr == 1) PG8_BAR;
        PG8_WAIT_V(4); PG8_BAR;
        PG8_STAGE(PG8_SB(1, 0), cB + kstep, voffB); PG8_STAGE(PG8_SA(1, 0), cA + kstep, voffA); PG8_STAGE(PG8_SB(1, 1), cB + hstep + kstep, voffB);
        PG8_WAIT_V(6); PG8_BAR;
    }
    for (;;) {
        const bool has_next = S.next(ui + 1, nxt);
        const char* nA = has_next ? (const char*)g.A + (size_t)nxt.pm * tstep : cA; const char* nB = has_next ? (const char*)g.Bt + (size_t)nxt.pn * tstep : cB;
        for (int t = 0; t < nt; t += 2) {
            const bool last = (t == nt - 2);
            const char* a1 = cA + (size_t)(t + 1) * kstep;
            const char* a2 = last ? nA : cA + (size_t)(t + 2) * kstep; const char* b2 = last ? nB : cB + (size_t)(t + 2) * kstep;
            const char* a3 = a2 + kstep; const char* b3 = b2 + kstep;
            if (last && has_next) S.a_ready(nxt);
            if constexpr (SP2) {
            PG8_LDB(B0, 0, 0); PG8_LDB(B1, 0, 1); PG8_SCHED; PG8_LDA(At, 0, 0); PG8_STAGE(PG8_SA(1, 1), a1 + hstep, voffA);
            PG8_WAIT_V(8); PG8_WAIT_L(0); PG8_BAR; PG8_MMA(0, 0, At, B0); PG8_MMA(0, 1, At, B1); PG8_BAR; PG8_SCHED;
            PG8_LDA(At, 0, 1); PG8_STAGE(PG8_SB(0, 0), b2, voffB); PG8_STAGE(PG8_SB(0, 1), b2 + hstep, voffB); PG8_STAGE(PG8_SA(0, 0), a2, voffA);
            PG8_WAIT_V(8); PG8_WAIT_L(0); PG8_BAR; PG8_MMA(1, 0, At, B0); PG8_MMA(1, 1, At, B1); PG8_BAR; PG8_SCHED;
            PG8_LDB(B0, 1, 0); PG8_LDB(B1, 1, 1); PG8_SCHED; PG8_LDA(At, 1, 0); PG8_STAGE(PG8_SA(0, 1), a2 + hstep, voffA);
            PG8_WAIT_V(8); PG8_WAIT_L(0); PG8_BAR; PG8_MMA(0, 0, At, B0); PG8_MMA(0, 1, At, B1); PG8_BAR; PG8_SCHED;
            PG8_LDA(At, 1, 1); PG8_STAGE(PG8_SB(1, 0), b3, voffB); PG8_STAGE(PG8_SB(1, 1), b3 + hstep, voffB); PG8_STAGE(PG8_SA(1, 0), a3, voffA);
            PG8_WAIT_V(8); PG8_WAIT_L(0); PG8_BAR; PG8_MMA(1, 0, At, B0); PG8_MMA(1, 1, At, B1); PG8_BAR; PG8_SCHED;
            } else {
            PG8_LDB(B0, 0, 0); PG8_SCHED; PG8_LDA(At, 0, 0); PG8_STAGE(PG8_SA(1, 1), a1 + hstep, voffA);
            PG8_WAIT_L(8); PG8_BAR; PG8_WAIT_L(0); PG8_MMA(0, 0, At, B0); PG8_BAR; PG8_SCHED;
            PG8_LDB(B1, 0, 1); PG8_STAGE(PG8_SB(0, 0), b2, voffB);
            PG8_BAR; PG8_WAIT_L(0); PG8_MMA(0, 1, At, B1); PG8_BAR;
            PG8_LDA(At, 0, 1); PG8_STAGE(PG8_SA(0, 0), a2, voffA);
            PG8_BAR; PG8_WAIT_L(0); PG8_MMA(1, 0, At, B0); PG8_BAR; PG8_SCHED;
            PG8_STAGE(PG8_SB(0, 1), b2 + hstep, voffB);
            PG8_WAIT_V(6); PG8_BAR; PG8_MMA(1, 1, At, B1); PG8_BAR;
            PG8_LDB(B0, 1, 0); PG8_SCHED; PG8_LDA(At, 1, 0); PG8_STAGE(PG8_SA(0, 1), a2 + hstep, voffA);
            PG8_WAIT_L(8); PG8_BAR; PG8_WAIT_L(0); PG8_MMA(0, 0, At, B0); PG8_BAR; PG8_SCHED;
            PG8_LDB(B1, 1, 1); PG8_STAGE(PG8_SB(1, 0), b3, voffB);
            PG8_BAR; PG8_WAIT_L(0); PG8_MMA(0, 1, At, B1); PG8_BAR;
            PG8_LDA(At, 1, 1); PG8_STAGE(PG8_SA(1, 0), a3, voffA);
            PG8_BAR; PG8_WAIT_L(0); PG8_MMA(1, 0, At, B0); PG8_BAR; PG8_SCHED;
            PG8_STAGE(PG8_SB(1, 1), b3 + hstep, voffB);
            PG8_WAIT_V(6); PG8_BAR; PG8_MMA(1, 1, At, B1); PG8_BAR;
            }
        }
        if constexpr (ALIGN_EPI) { if (wr == 0) PG8_BAR; }
        if constexpr (!Epi::AFTER_DRAIN) { E(acc, cur, wr, wc, fr, fq); S.done(cur); }
        if (!has_next) break;
#pragma unroll
        for (int a = 0; a < 2; ++a)
#pragma unroll
            for (int b = 0; b < 2; ++b)
#pragma unroll
                for (int m = 0; m < 4; ++m)
#pragma unroll
                    for (int n = 0; n < 2; ++n) acc[a][b][m][n] = (f32x4){0.f, 0.f, 0.f, 0.f};
        cur = nxt; cA = nA; cB = nB; ++ui;
        if constexpr (ALIGN_EPI) { if (wr == 1) PG8_BAR; }
    }
    PG8_WAIT_V(0);
    if constexpr (!ALIGN_EPI) { if (wr == 0) PG8_BAR; }
    PG8_BAR;
    if constexpr (Epi::AFTER_DRAIN) { E.fused(acc, cur, wr, wc, fr, fq, lds, wid, lane); S.done(cur); }
#undef PG8_SA
#undef PG8_SB
#undef PG8_STAGE
#undef PG8_LDA
#undef PG8_LDB
#undef PG8_MMA
#undef PG8_WAIT_V
#undef PG8_WAIT_L
#undef PG8_BAR
#undef PG8_SCHED
}
}
#define XB_TMO      128
#define XB_XCNT(j)  (256  + 64 * (j))
#define XB_XSUB(j)  (1280 + 64 * (j))
#define XB_XGEN(j)  (2304 + 64 * (j))
#define XB_TOP      3328
#define XB_TOPGEN   3392
#define XCD_BAR_WORDS 3456
#define XB_SPIN_CAP (1u << 18)
#define XLAS __attribute__((address_space(3)))

__device__ __forceinline__ unsigned xb_ld(unsigned* p)              { return __hip_atomic_load(p, __ATOMIC_RELAXED, __HIP_MEMORY_SCOPE_AGENT); }
__device__ __forceinline__ unsigned xb_add(unsigned* p, unsigned v) { return __hip_atomic_fetch_add(p, v, __ATOMIC_RELAXED, __HIP_MEMORY_SCOPE_AGENT); }
__device__ __forceinline__ unsigned xb_xcc_id() { return (unsigned)__builtin_amdgcn_s_getreg((3 << 11) | 20) & 0xFu; }
#define XB_SPIN(cond, bar) do { unsigned _sp = 0; while (cond) { __builtin_amdgcn_s_sleep(1); \
    if ((++_sp & 255u) == 0u) { if (xb_ld(&(bar)[XB_TMO])) break; if (_sp > XB_SPIN_CAP) { atomicAdd(&(bar)[XB_TMO], 1u); break; } } } } while (0)

struct XcdBarrier {
    unsigned* bar; unsigned x;
    volatile XLAS unsigned* st;
};

__device__ __forceinline__ XcdBarrier xcd_barrier_post(unsigned* bar, volatile XLAS unsigned* st) {
    XcdBarrier b; b.bar = bar; b.x = xb_xcc_id(); b.st = st;
    if (threadIdx.x == 0) (void)xb_add(&bar[XB_XCNT(b.x)], 1u);
    return b;
}
__device__ __forceinline__ void xcd_barrier_complete(unsigned* bar, unsigned x, unsigned& nloc, unsigned& nx) {
    const unsigned G = gridDim.x * gridDim.y * gridDim.z;
    unsigned sum, cnt, mine, sp = 0u;
    for (;;) {
        sum = 0u; cnt = 0u; mine = 0u;
#pragma unroll
        for (unsigned j = 0; j < 16; ++j) { const unsigned c = xb_ld(&bar[XB_XCNT(j)]); sum += c; cnt += (c > 0u) ? 1u : 0u; mine = (j == x) ? c : mine; }
        if (sum == G) break;
        __builtin_amdgcn_s_sleep(1);
        if ((++sp & 255u) == 0u) { if (xb_ld(&bar[XB_TMO])) break; if (sp > XB_SPIN_CAP) { atomicAdd(&bar[XB_TMO], 1u); break; } }
    }
    nloc = mine > 0u ? mine : 1u; nx = cnt > 0u ? cnt : 1u;
}

__device__ __forceinline__ void xcd_barrier(const XcdBarrier& b) {
    asm volatile("s_waitcnt vmcnt(0)" ::: "memory");
    __syncthreads();
    if (threadIdx.x == 0) {
        unsigned* bar = b.bar;
        __builtin_amdgcn_s_waitcnt(0);
        unsigned nloc = b.st[0], nx = b.st[1];
        if (nloc == 0u) { xcd_barrier_complete(bar, b.x, nloc, nx); b.st[0] = nloc; b.st[1] = nx; }
        const unsigned old = xb_add(&bar[XB_XSUB(b.x)], 1u);
        const unsigned gen = old / nloc;
        if (old + 1u == (gen + 1u) * nloc) {
            __builtin_amdgcn_fence(__ATOMIC_RELEASE, "agent");
            asm volatile("s_waitcnt vmcnt(0)" ::: "memory");
            const unsigned og = xb_add(&bar[XB_TOP], 1u);
            const unsigned tg = og / nx;
            if (og + 1u == (tg + 1u) * nx) xb_add(&bar[XB_TOPGEN], 1u);
            else XB_SPIN(xb_ld(&bar[XB_TOPGEN]) == tg, bar);
            __builtin_amdgcn_fence(__ATOMIC_ACQUIRE, "agent");
            xb_add(&bar[XB_XGEN(b.x)], 1u);
            asm volatile("s_waitcnt vmcnt(0)" ::: "memory");
        } else {
            XB_SPIN(xb_ld(&bar[XB_XGEN(b.x)]) == gen, bar);
            __builtin_amdgcn_fence(__ATOMIC_ACQUIRE, "agent");
            asm volatile("s_waitcnt vmcnt(0)" ::: "memory");
        }
    }
    __syncthreads();
}

using pg8::bf16_t; using pg8::bf16x8; using pg8::f32x4; using pg8::u32x4;
typedef float f32x16 __attribute__((ext_vector_type(16)));
typedef unsigned u32x2 __attribute__((ext_vector_type(2)));
#define LAS __attribute__((address_space(3)))

constexpr int D = 2048, NBATCH = 8, T = 2048, M = NBATCH * T, FFN = 5632, DINP = 6656;
constexpr int NTHR = 512;
constexpr int LDS_BYTES = 143360;

constexpr size_t al256(size_t x) { return (x + 255) & ~(size_t)255; }
constexpr size_t OFF_CTL = 0;
constexpr size_t OFF_LAM = 4096;
constexpr size_t OFF_HID3 = 8192;
constexpr size_t OFF_WIN = OFF_HID3 + (size_t)2 * 2048 * 64 * 4;
constexpr size_t OFF_WG = OFF_WIN + (size_t)DINP * 2048 * 2;
constexpr size_t OFF_WBR = OFF_WG + (size_t)8192 * 2048 * 2;
constexpr size_t OFF_WO = OFF_WBR + (size_t)2048 * 2560 * 2;
constexpr size_t OFF_WLORA = OFF_WO + (size_t)2048 * 2048 * 2;
constexpr size_t OFF_WGUP = OFF_WLORA + (size_t)2 * 1024 * 256 * 2;
constexpr size_t OFF_H = OFF_WGUP + (size_t)512 * 256 * 2;
constexpr size_t OFF_OA = OFF_H + (size_t)M * 2048 * 2;
constexpr size_t OFF_OB = OFF_OA + (size_t)M * 1024 * 2;
constexpr size_t OFF_OC = OFF_OB + (size_t)M * 512 * 2;
constexpr size_t OFF_OD = OFF_OC + (size_t)M * 512 * 2;
constexpr size_t OFF_MERGED = OFF_OA;
constexpr size_t OFF_BIG = OFF_OD + (size_t)M * 512 * 2;
constexpr size_t OFF_BUFA = OFF_BIG;
constexpr size_t OFF_BUFB = OFF_BUFA + (size_t)M * 1536 * 2;
constexpr size_t OFF_BUFD = OFF_BUFB + (size_t)M * 1536 * 2;
constexpr size_t OFF_BUFC = OFF_BUFD + (size_t)M * 1536 * 2;
constexpr size_t OFF_SLD = OFF_BUFC + (size_t)M * 2048 * 2;
constexpr size_t OFF_SA = OFF_SLD + (size_t)2 * M * 512 * 2;
constexpr size_t OFF_ZT = OFF_SA + (size_t)2 * M * 512 * 2;
constexpr size_t OFF_VTA = OFF_ZT + (size_t)512 * 8 * 2048 * 2;
constexpr size_t OFF_VTD = OFF_VTA + (size_t)8 * 256 * 2048 * 2;
constexpr size_t OFF_GBUF = OFF_VTD + (size_t)8 * 512 * 2048 * 2;
constexpr size_t OFF_OCDIR = OFF_GBUF + (size_t)M * 512 * 2;
constexpr size_t OFF_YT = OFF_OCDIR + (size_t)2 * M * 512 * 2;
constexpr size_t OFF_ALO = OFF_YT;
constexpr size_t OFF_AG = OFF_ALO + (size_t)2 * M * 256 * 2;
constexpr size_t OFF_BIGEND = OFF_YT + (size_t)512 * 8 * 2048 * 4;
constexpr size_t OFF_P = OFF_BIG;
constexpr size_t OFF_ACT = OFF_BIG;
constexpr size_t OFF_XBAR = OFF_BIGEND;
constexpr size_t OFF_WFF = OFF_BIGEND + 16384;
constexpr size_t OFF_WD = OFF_WFF + (size_t)11264 * 2048 * 2;
constexpr size_t WS_END = OFF_WD + (size_t)2048 * FFN * 2;
static_assert(OFF_P + (size_t)M * 8192 * 2 <= OFF_BIGEND, "P alias");
static_assert(OFF_AG + (size_t)M * 256 * 2 <= OFF_BIGEND, "Ag alias");
static_assert(WS_END <= 732154368ull, "workspace");

struct Args { const float* in[40]; float* out; unsigned char* ws; };
extern __shared__ __attribute__((aligned(16))) unsigned char g_smem[];

typedef __attribute__((address_space(1))) unsigned char gas_uchar;
__device__ __forceinline__ unsigned char* launder_ws(unsigned char* p) { gas_uchar* g = (gas_uchar*)p; asm volatile("" : "+s"(g)); return (unsigned char*)g; }
__device__ __forceinline__ float bf2f(bf16_t v) { return __uint_as_float(((unsigned)v) << 16); }
__device__ __forceinline__ float bflo(unsigned v) { return __uint_as_float(v << 16); }
__device__ __forceinline__ float bfhi(unsigned v) { return __uint_as_float(v & 0xffff0000u); }
typedef float f32x2c_ __attribute__((ext_vector_type(2)));
typedef __bf16 bf16x2c_ __attribute__((ext_vector_type(2)));
__device__ __forceinline__ unsigned pk2(float lo, float hi) { const f32x2c_ v = {lo, hi}; const bf16x2c_ b = __builtin_convertvector(v, bf16x2c_); return __builtin_bit_cast(unsigned, b); }
__device__ __forceinline__ bf16_t f2bf(float f) { return (bf16_t)(pk2(f, 0.f) & 0xffffu); }
__device__ __forceinline__ int ltid() { int t = threadIdx.x; asm volatile("" : "+v"(t)); return t; }
__device__ __forceinline__ int lbid() { int b = blockIdx.x; asm volatile("" : "+s"(b)); return b; }
__device__ __forceinline__ float shx(float v, int mask, int lane) { return __int_as_float(__builtin_amdgcn_ds_bpermute((lane ^ mask) << 2, __float_as_int(v))); }
template <int CTRL> __device__ __forceinline__ float dppf(float v) { return __int_as_float(__builtin_amdgcn_update_dpp(0, __float_as_int(v), CTRL, 0xF, 0xF, true)); }
__device__ __forceinline__ float wave_sum(float v, int lane) {
    v += dppf<0xB1>(v); v += dppf<0x4E>(v); v += dppf<0x141>(v); v += dppf<0x140>(v);
    v += shx(v, 16, lane);
    return v + shx(v, 32, lane);
}
__device__ __forceinline__ float half_sum(float v, int lane) {
    v += dppf<0xB1>(v); v += dppf<0x4E>(v); v += dppf<0x141>(v); v += dppf<0x140>(v);
    return v + shx(v, 16, lane);
}
__device__ __forceinline__ float sum8(float v) {
    v += dppf<0xB1>(v); v += dppf<0x4E>(v); v += dppf<0x141>(v); return v;
}
__device__ __forceinline__ float sigmoidf_(float x) { return __builtin_amdgcn_rcpf(1.f + __expf(-x)); }
__device__ __forceinline__ float sig2_(float z) { return __builtin_amdgcn_rcpf(1.f + __builtin_amdgcn_exp2f(-z)); }

struct EpiIn {
    static constexpr bool PERM = true, AFTER_DRAIN = false;
    bf16_t *bA, *bB, *bD, *bC;
    __device__ __forceinline__ void operator()(const f32x4 (&acc)[2][2][4][2], const pg8::Unit& u, int wr, int wc, int fr, int fq) const {
        bf16_t* base; int ldc, ct;
        if (u.pn < 6) { base = bA; ldc = 1536; ct = u.pn; } else if (u.pn < 12) { base = bB; ldc = 1536; ct = u.pn - 6; }
        else if (u.pn < 18) { base = bD; ldc = 1536; ct = u.pn - 12; } else { base = bC; ldc = 2048; ct = u.pn - 18; }
        const int row0 = u.pm * 256 + wr * 64 + fr, col0 = ct * 256 + wc * 32 + 8 * fq;
#pragma unroll
        for (int ai = 0; ai < 2; ++ai)
#pragma unroll
            for (int m = 0; m < 4; ++m) { bf16_t* rowp = base + (size_t)(row0 + ai * 128 + m * 16) * ldc + col0;
#pragma unroll
                for (int bj = 0; bj < 2; ++bj) { const f32x4 v0 = acc[ai][bj][m][0], v1 = acc[ai][bj][m][1];
                    u32x4 w; w.x = pk2(v0[0], v0[1]); w.y = pk2(v0[2], v0[3]); w.z = pk2(v1[0], v1[1]); w.w = pk2(v1[2], v1[3]);
                    *(u32x4*)(rowp + bj * 128) = w; } }
    }
};
struct EpiBf {
    static constexpr bool PERM = true, AFTER_DRAIN = false;
    bf16_t* O; int ldc; int coff;
    __device__ __forceinline__ void operator()(const f32x4 (&acc)[2][2][4][2], const pg8::Unit& u, int wr, int wc, int fr, int fq) const {
        const int row0 = u.pm * 256 + wr * 64 + fr, col0 = coff + u.pn * 256 + wc * 32 + 8 * fq;
#pragma unroll
        for (int ai = 0; ai < 2; ++ai)
#pragma unroll
            for (int m = 0; m < 4; ++m) { bf16_t* rowp = O + (size_t)(row0 + ai * 128 + m * 16) * ldc + col0;
#pragma unroll
                for (int bj = 0; bj < 2; ++bj) { const f32x4 v0 = acc[ai][bj][m][0], v1 = acc[ai][bj][m][1];
                    u32x4 w; w.x = pk2(v0[0], v0[1]); w.y = pk2(v0[2], v0[3]); w.z = pk2(v1[0], v1[1]); w.w = pk2(v1[2], v1[3]);
                    *(u32x4*)(rowp + bj * 128) = w; } }
    }
};
struct EpiGate {
    static constexpr bool PERM = false, AFTER_DRAIN = false;
    const bf16_t* P; bf16_t* Mg;
    __device__ __forceinline__ void operator()(const f32x4 (&acc)[2][2][4][2], const pg8::Unit& u, int wr, int wc, int fr, int fq) const {
        const int row0 = u.pm * 256 + wr * 64 + fr, col0 = u.pn * 64 + wc * 16 + 4 * fq;
#pragma unroll
        for (int ai = 0; ai < 2; ++ai)
#pragma unroll
            for (int m = 0; m < 4; ++m) { const size_t row = (size_t)(row0 + ai * 128 + m * 16);
                f32x4 o = {0.f, 0.f, 0.f, 0.f};
#pragma unroll
                for (int g = 0; g < 4; ++g) { const u32x2 pv = *(const u32x2*)(P + row * 8192 + g * 2048 + col0); const f32x4 gv = acc[ai][g >> 1][m][g & 1];
                    o[0] += sig2_(gv[0]) * bflo(pv.x); o[1] += sig2_(gv[1]) * bfhi(pv.x); o[2] += sig2_(gv[2]) * bflo(pv.y); o[3] += sig2_(gv[3]) * bfhi(pv.y); }
                u32x2 w; w.x = pk2(o[0], o[1]); w.y = pk2(o[2], o[3]);
                *(u32x2*)(Mg + row * 2048 + col0) = w; }
    }
};
struct EpiRes {
    static constexpr bool PERM = false, AFTER_DRAIN = false;
    const float* base; float* out;
    __device__ __forceinline__ void operator()(const f32x4 (&acc)[2][2][4][2], const pg8::Unit& u, int wr, int wc, int fr, int fq) const {
        const int row0 = u.pm * 256 + wr * 64 + fr, col0 = u.pn * 256 + wc * 32 + 4 * fq;
#pragma unroll
        for (int ai = 0; ai < 2; ++ai)
#pragma unroll
            for (int m = 0; m < 4; ++m) { const size_t off = (size_t)(row0 + ai * 128 + m * 16) * 2048 + col0;
#pragma unroll
                for (int bj = 0; bj < 2; ++bj)
#pragma unroll
                    for (int n = 0; n < 2; ++n) { const f32x4 bs = *(const f32x4*)(base + off + bj * 128 + n * 16); *(f32x4*)(out + off + bj * 128 + n * 16) = bs + acc[ai][bj][m][n]; } }
    }
};
struct EpiFfn {
    static constexpr bool PERM = true, AFTER_DRAIN = false;
    bf16_t* act;
    __device__ __forceinline__ void operator()(const f32x4 (&acc)[2][2][4][2], const pg8::Unit& u, int wr, int wc, int fr, int fq) const {
        const int row0 = u.pm * 256 + wr * 64 + fr, col0 = u.pn * 128 + wc * 32 + 8 * fq;
#pragma unroll
        for (int ai = 0; ai < 2; ++ai)
#pragma unroll
            for (int m = 0; m < 4; ++m) { bf16_t* rowp = act + (size_t)(row0 + ai * 128 + m * 16) * FFN + col0;
                const f32x4 g0 = acc[ai][0][m][0], g1 = acc[ai][0][m][1], u0 = acc[ai][1][m][0], u1 = acc[ai][1][m][1]; f32x4 o0, o1;
#pragma unroll
                for (int j = 0; j < 4; ++j) { o0[j] = g0[j] * sigmoidf_(g0[j]) * u0[j]; o1[j] = g1[j] * sigmoidf_(g1[j]) * u1[j]; }
                u32x4 w; w.x = pk2(o0[0], o0[1]); w.y = pk2(o0[2], o0[3]); w.z = pk2(o1[0], o1[1]); w.w = pk2(o1[2], o1[3]);
                *(u32x4*)rowp = w; }
    }
};
template <class Epi> __device__ __forceinline__ void run_gemm(unsigned char* smem, const bf16_t* A, const bf16_t* Bt, int N, int K, const Epi& E) {
    pg8::Gemm g; g.A = A; g.Bt = Bt; g.M = M; g.N = N; g.K = K;
    pg8::StaticOrder S; S.init(M, N, (int)gridDim.x, lbid());
    __syncthreads();
#if PG8_V2
    pg8::gemm_phase<Epi, pg8::StaticOrder, true, PG8_SP2>((PG8_LAS unsigned char*)g_smem, g, S, E);
#else
    pg8::gemm_phase<Epi, pg8::StaticOrder, false>((PG8_LAS unsigned char*)g_smem, g, S, E, nullptr);
#endif
    __syncthreads();
}
__device__ __forceinline__ const float* wsrc(const Args& a, int mat, int l, int np, bool& valid, size_t& ld) {
    valid = true;
    if (mat == 0) { const int sc = np < 3072 ? np : (np < 4608 ? np + 1984 : (np < 6592 ? np - 1536 : -1)); valid = sc >= 0; ld = 6592; return a.in[2] + (size_t)l * 2048 * 6592 + (sc >= 0 ? sc : 0); }
    if (mat == 1) { const int pn = np >> 8, c = np & 255, g = 2 * (c >> 7) + ((c >> 4) & 1), col = 64 * pn + 16 * ((c >> 5) & 3) + (c & 15); ld = 2048; return a.in[32] + ((size_t)(l * 4 + g) * 2048) * 2048 + col; }
    if (mat <= 5) { const int g = mat - 2, koff = g == 0 ? 0 : 1024 + (g - 1) * 512; ld = 2048; return a.in[33] + (size_t)l * 2560 * 2048 + (size_t)koff * 2048 + np; }
    if (mat == 6) { ld = 2048; return a.in[34] + (size_t)l * 2048 * 2048 + np; }
    if (mat == 7) { const int pn = np >> 8, c = np & 255, ty = c >> 7, col = 128 * pn + (c & 127); ld = FFN; return (ty ? a.in[37] : a.in[36]) + (size_t)l * 2048 * FFN + col; }
    ld = 2048; return a.in[38] + (size_t)l * FFN * 2048 + np;
}
struct WItem { int mat, kt, ng, K; bf16_t* dst; };
__device__ __forceinline__ void witem_load(const Args& a, int l, const WItem& w, float (&rg)[32]) {
    const int tid = ltid(), kr = tid >> 6, n4 = tid & 63, k0 = w.kt * 64;
    bool vd; size_t ld = 0; const float* sp = wsrc(a, w.mat, l, w.ng * 256 + 4 * n4, vd, ld);
    const float wscale = w.mat == 1 ? 1.4426950408889634f : 1.f;
#pragma unroll
    for (int i = 0; i < 8; ++i) { f32x4 v = {0.f, 0.f, 0.f, 0.f}; if (vd) v = *(const f32x4*)(sp + (size_t)(k0 + kr + 8 * i) * ld) * wscale;
        rg[4 * i] = v[0]; rg[4 * i + 1] = v[1]; rg[4 * i + 2] = v[2]; rg[4 * i + 3] = v[3]; }
}
__device__ __forceinline__ void witem_tolds(float* tile, const float (&rg)[32]) {
    const int tid = ltid(), kr = tid >> 6, n4 = tid & 63, q = n4 >> 4, nc = (n4 & 15) * 4;
#pragma unroll
    for (int i = 0; i < 8; ++i)
#pragma unroll
        for (int e = 0; e < 4; ++e) tile[q * 4160 + (kr + 8 * i) * 65 + nc + e] = rg[4 * i + e];
}
__device__ __forceinline__ void witem_store(const WItem& w, const float* tile) {
    const int tid = ltid(), nr = tid >> 3, kc = tid & 7, k0 = w.kt * 64;
#pragma unroll
    for (int q = 0; q < 4; ++q) { const float* tp = tile + q * 4160 + (kc * 8) * 65 + nr;
        u32x4 o; o.x = pk2(tp[0], tp[65]); o.y = pk2(tp[130], tp[195]); o.z = pk2(tp[260], tp[325]); o.w = pk2(tp[390], tp[455]);
        *(u32x4*)(w.dst + (size_t)((w.ng * 4 + q) * 64 + nr) * w.K + k0 + kc * 8) = o; }
}
__device__ __forceinline__ WItem witem_phase0(unsigned char* wsl, int it) {
    constexpr int I0 = 26 * 32, I1 = 32 * 32, I2 = 8 * 16, I3 = 8 * 8;
    WItem w; int r = it;
    if (r < I0) { w.mat = 0; w.kt = r / 26; w.ng = r % 26; w.K = 2048; w.dst = (bf16_t*)(wsl + OFF_WIN); return w; }
    r -= I0;
    if (r < I1) { w.mat = 1; w.kt = r / 32; w.ng = r % 32; w.K = 2048; w.dst = (bf16_t*)(wsl + OFF_WG); return w; }
    r -= I1;
    if (r < I2) { w.mat = 2; w.kt = r / 8; w.ng = r % 8; w.K = 1024; w.dst = (bf16_t*)(wsl + OFF_WBR); return w; }
    r -= I2;
    if (r < 3 * I3) { const int g = 1 + r / I3; r = r % I3; w.mat = 2 + g; w.kt = r / 8; w.ng = r % 8; w.K = 512; w.dst = (bf16_t*)(wsl + OFF_WBR) + (size_t)2048 * 1024 + (size_t)(g - 1) * 2048 * 512; return w; }
    r -= 3 * I3;
    w.mat = 6; w.kt = r / 8; w.ng = r % 8; w.K = 2048; w.dst = (bf16_t*)(wsl + OFF_WO); return w;
}
__device__ __forceinline__ WItem witem_phase8(unsigned char* wsl, int it) {
    constexpr int I0 = 44 * 32;
    WItem w; int r = it;
    if (r < I0) { w.mat = 7; w.kt = r / 44; w.ng = r % 44; w.K = 2048; w.dst = (bf16_t*)(wsl + OFF_WFF); return w; }
    r -= I0;
    w.mat = 8; w.kt = r / 8; w.ng = r % 8; w.K = FFN; w.dst = (bf16_t*)(wsl + OFF_WD); return w;
}
template <int PH> __device__ __forceinline__ void wconv_run(const Args& a, unsigned char* smem, unsigned char* wsl, int l, int nit, int first = 0) {
    float* tile = (float*)smem;
    const int bid_ = lbid() + first, G = gridDim.x;
    if (bid_ >= nit) return;
    float rg[32];
    WItem cur = PH == 0 ? witem_phase0(wsl, bid_) : witem_phase8(wsl, bid_);
    witem_load(a, l, cur, rg);
    for (int it = bid_; it < nit; it += G) {
        witem_tolds(tile, rg);
        __syncthreads();
        const bool more = it + G < nit;
        WItem nxt = cur;
        if (more) { nxt = PH == 0 ? witem_phase0(wsl, it + G) : witem_phase8(wsl, it + G); witem_load(a, l, nxt, rg); }
        witem_store(cur, tile);
        __syncthreads();
        cur = nxt;
    }
}
__device__ __forceinline__ void wconv_phase0(const Args& a, unsigned char* smem, int l) {
    unsigned char* wsl = launder_ws(a.ws); const int bid_ = lbid();
    constexpr int NIT = 26 * 32 + 32 * 32 + 8 * 16 + 3 * 8 * 8 + 8 * 32;
    wconv_run<0>(a, smem, wsl, l, 26 * 32);
    bf16_t* wl = (bf16_t*)(wsl + OFF_WLORA); bf16_t* wg = (bf16_t*)(wsl + OFF_WGUP);
    const int gt = bid_ * NTHR + ltid(), GT = gridDim.x * NTHR;
    for (int i = gt; i < 2 * 1024 * 256; i += GT) { const int d = i >> 18, np = (i >> 8) & 1023, k = i & 255; float v = 0.f;
        if (np < 512) { if (k < 96) v = a.in[18][((size_t)(l * 2 + d) * 96 + k) * 512 + np]; }
        else { if (k >= 96 && k < 192) v = a.in[20][((size_t)(l * 2 + d) * 96 + (k - 96)) * 512 + (np - 512)]; }
        wl[i] = f2bf(v); }
    for (int i = gt; i < 512 * 256; i += GT) { const int np = i >> 8, k = i & 255; wg[i] = f2bf(a.in[21][((size_t)l * 256 + k) * 512 + np]); }
}
__device__ __forceinline__ void wconv_phase8(const Args& a, unsigned char* smem, int l) {
    unsigned char* wsl = launder_ws(a.ws);
    wconv_run<8>(a, smem, wsl, l, 44 * 32 + 8 * 88);
}
template <bool TOBF, bool COPY = false> __device__ __forceinline__ void rmsnorm_rows(const float* x, const float* g, bf16_t* hout, float* fout, float* xcopy = nullptr) {
    const int tid_ = ltid(), lane = tid_ & 63, wave = tid_ >> 6, bid_ = lbid();
    f32x4 gv[8];
#pragma unroll
    for (int j = 0; j < 8; ++j) gv[j] = ((const f32x4*)g)[lane + 64 * j];
    for (int row = bid_ * 8 + wave; row < M; row += gridDim.x * 8) {
        const f32x4* xr = (const f32x4*)(x + (size_t)row * 2048) + lane;
        f32x4 v[8];
#pragma unroll
        for (int j = 0; j < 8; ++j) v[j] = xr[64 * j];
        asm volatile("" : "+v"(v[0]), "+v"(v[1]), "+v"(v[2]), "+v"(v[3]), "+v"(v[4]), "+v"(v[5]), "+v"(v[6]), "+v"(v[7]));
        float ss = 0.f;
#pragma unroll
        for (int j = 0; j < 8; ++j) ss += (v[j][0] * v[j][0] + v[j][1] * v[j][1]) + (v[j][2] * v[j][2] + v[j][3] * v[j][3]);
        if (COPY) {
#pragma unroll
            for (int j = 0; j < 8; ++j) ((f32x4*)(xcopy + (size_t)row * 2048))[lane + 64 * j] = v[j]; }
        ss = wave_sum(ss, lane);
        const float r = rsqrtf(ss * (1.f / 2048.f) + 1e-6f);
#pragma unroll
        for (int j = 0; j < 8; ++j) { const f32x4 o = v[j] * r * gv[j];
            if (TOBF) { u32x2 w; w.x = pk2(o[0], o[1]); w.y = pk2(o[2], o[3]); ((u32x2*)(hout + (size_t)row * 2048))[lane + 64 * j] = w; }
            else ((f32x4*)(fout + (size_t)row * 2048))[lane + 64 * j] = o; }
    }
}
__device__ __forceinline__ void hid3_and_lam(const Args& a) {
    unsigned char* wsl = launder_ws(a.ws); const int bid_ = lbid();
    const int tid_ = ltid(), lane = tid_ & 63, wave = tid_ >> 6;
    float* hid3 = (float*)(wsl + OFF_HID3);
    for (int it = bid_ * 8 + wave; it < 2 * 2048; it += gridDim.x * 8) {
        const int l = it >> 11, j = it & 2047;
        const float* w1 = a.in[7] + l * 33 * 64; const float* b1 = a.in[8] + l * 64; const float* w2 = a.in[9] + l * 4096; const float* b2 = a.in[10] + l * 64;
        const float* w3 = a.in[11] + l * 4096; const float* b3 = a.in[12] + l * 64; const float fr = a.in[14][l * 64 + lane];
        float ze = 0.f;
        if (lane == 0) ze = (float)j / 2047.f;
        else if (lane < 33) { const int bnd = (lane - 1) & 15; const float band = 1e-4f + (float)bnd * ((15.f - 1e-4f) / 15.f);
            const float ang = ((6.283185307179586f / 2048.f) * (float)j) * band; ze = lane < 17 ? cosf(ang) : -sinf(ang); }
        float acc = b1[lane];
        for (int e = 0; e < 33; ++e) acc += __int_as_float(__builtin_amdgcn_ds_bpermute(e << 2, __float_as_int(ze))) * w1[e * 64 + lane];
        const float h1 = sinf(fr * acc);
        acc = b2[lane];
        for (int e = 0; e < 64; ++e) acc += __int_as_float(__builtin_amdgcn_ds_bpermute(e << 2, __float_as_int(h1))) * w2[e * 64 + lane];
        const float h2 = sinf(fr * acc);
        acc = b3[lane];
        for (int e = 0; e < 64; ++e) acc += __int_as_float(__builtin_amdgcn_ds_bpermute(e << 2, __float_as_int(h2))) * w3[e * 64 + lane];
        hid3[(size_t)it * 64 + lane] = sinf(fr * acc);
    }
    if (bid_ == 0 && wave < 2) { const int l = wave;
        const float s1 = wave_sum(a.in[27][l * 64 + lane] * a.in[28][l * 64 + lane], lane), s2 = wave_sum(a.in[29][l * 64 + lane] * a.in[30][l * 64 + lane], lane);
        const float lam_init = 0.8f - 0.6f * expf(-0.3f * (float)l);
        if (lane == 0) ((float*)(wsl + OFF_LAM))[l] = expf(s1) - expf(s2) + lam_init; }
}
__device__ __forceinline__ float conv3(const bf16_t* bufB, size_t tok, int t, int col, const float* cw, const float* cb) {
    const float u0 = t > 0 ? bf2f(bufB[(tok - 1) * 1536 + col]) : 0.f, u1 = bf2f(bufB[tok * 1536 + col]), u2 = t < T - 1 ? bf2f(bufB[(tok + 1) * 1536 + col]) : 0.f;
    return cw[col] * u0 + cw[1536 + col] * u1 + cw[3072 + col] * u2 + cb[col];
}
__device__ __forceinline__ void tr_store(const bf16_t* tile, bf16_t* dst, size_t rowbase, size_t cmul, int t0) {
    const int tid_ = ltid(), cl = tid_ >> 3, tch = tid_ & 7;
    const u32x4 v = *(const u32x4*)(tile + cl * 72 + tch * 8);
    *(u32x4*)(dst + (rowbase + (size_t)cl * cmul) * T + t0 + tch * 8) = v;
}
__device__ __forceinline__ void prep_phase(const Args& a, unsigned char* smem, int l) {
    unsigned char* wsl = launder_ws(a.ws); const int bid_ = lbid();
    const int tid = ltid(), lane = tid & 63, wave = tid >> 6;
    bf16_t* bufA = (bf16_t*)(wsl + OFF_BUFA); const bf16_t* bufB = (const bf16_t*)(wsl + OFF_BUFB); const bf16_t* bufC = (const bf16_t*)(wsl + OFF_BUFC); const bf16_t* bufD = (const bf16_t*)(wsl + OFF_BUFD);
    {
        const int aa = lane >> 5, i = lane & 31;
        const float invf = exp2f(-(float)(2 * i) * (13.287712379549449f / 64.f));
        const float* qn = a.in[3] + l * 128; const float* kn = a.in[4] + l * 128;
        const float gq0 = qn[aa * 64 + i], gq1 = qn[aa * 64 + 32 + i], gk0 = kn[aa * 64 + i], gk1 = kn[aa * 64 + 32 + i];
        bf16_t* alo = (bf16_t*)(wsl + OFF_ALO); bf16_t* ag = (bf16_t*)(wsl + OFF_AG);
        const float* mu0 = a.in[16] + (size_t)(l * 2 + 0) * 1728; const float* mu1 = a.in[16] + (size_t)(l * 2 + 1) * 1728;
        for (int tok = bid_ * 8 + wave; tok < M; tok += gridDim.x * 8) {
            const int t = tok & (T - 1);
            const float pos = aa == 0 ? (float)(t >> 6) : (float)(t & 63);
            const float ang = pos * invf, cs = cosf(ang), sn = sinf(ang);
            bf16_t* row = bufA + (size_t)tok * 1536;
            float xa[10], xb[10];
#pragma unroll
            for (int hd = 0; hd < 10; ++hd) { const bf16_t* p = row + hd * 128 + aa * 64 + i; xa[hd] = bf2f(p[0]); xb[hd] = bf2f(p[32]); }
#pragma unroll
            for (int hd = 0; hd < 10; ++hd) {
                bf16_t* p = row + hd * 128 + aa * 64 + i;
                const float x0 = xa[hd], x1 = xb[hd];
                const float ss = wave_sum(x0 * x0 + x1 * x1, lane);
                const float r = rsqrtf(ss * (1.f / 128.f) + 1e-6f);
                const float y0 = x0 * r * (hd < 8 ? gq0 : gk0), y1 = x1 * r * (hd < 8 ? gq1 : gk1);
                p[0] = f2bf(y0 * cs - y1 * sn); p[32] = f2bf(y1 * cs + y0 * sn);
            }
            const bf16_t* crow = bufC + (size_t)tok * 2048;
            u32x2 o0 = {0u, 0u}, o1 = {0u, 0u};
            if (lane < 48) {
                const int col = 1536 + lane * 4;
                const u32x2 xc = *(const u32x2*)(crow + col);
                u32x2 xp = {0u, 0u}, xn = {0u, 0u};
                if (t > 0) xp = *(const u32x2*)(crow - 2048 + col);
                if (t < T - 1) xn = *(const u32x2*)(crow + 2048 + col);
                const float c4[4] = {bflo(xc.x), bfhi(xc.x), bflo(xc.y), bfhi(xc.y)};
                const float p4[4] = {bflo(xp.x), bfhi(xp.x), bflo(xp.y), bfhi(xp.y)};
                const float n4[4] = {bflo(xn.x), bfhi(xn.x), bflo(xn.y), bfhi(xn.y)};
                float f0[4], f1[4];
#pragma unroll
                for (int j = 0; j < 4; ++j) { f0[j] = c4[j] + (p4[j] - c4[j]) * mu0[col + j]; f1[j] = c4[j] + (n4[j] - c4[j]) * mu1[col + j];
                    if (lane < 24) { f0[j] = tanhf(f0[j]); f1[j] = tanhf(f1[j]); } }
                o0.x = pk2(f0[0], f0[1]); o0.y = pk2(f0[2], f0[3]); o1.x = pk2(f1[0], f1[1]); o1.y = pk2(f1[2], f1[3]);
            }
            *(u32x2*)(alo + (size_t)tok * 256 + lane * 4) = o0;
            *(u32x2*)(alo + (size_t)(M + tok) * 256 + lane * 4) = o1;
            { const u32x2 xg = *(const u32x2*)(crow + 1728 + lane * 4); u32x2 og;
              og.x = pk2(sigmoidf_(bflo(xg.x)), sigmoidf_(bfhi(xg.x))); og.y = pk2(sigmoidf_(bflo(xg.y)), sigmoidf_(bfhi(xg.y)));
              *(u32x2*)(ag + (size_t)tok * 256 + lane * 4) = og; }
        }
    }
    __syncthreads();
    {
        bf16_t* tile = (bf16_t*)smem;
        bf16_t* zT = (bf16_t*)(wsl + OFF_ZT); bf16_t* vta = (bf16_t*)(wsl + OFF_VTA); bf16_t* vtd = (bf16_t*)(wsl + OFF_VTD);
        const float* cw = a.in[5] + (size_t)l * 3 * 1536; const float* cb = a.in[6] + (size_t)l * 1536;
        const int tl = tid >> 3, c0l = (tid & 7) * 8;
        constexpr int NZ = 8 * 32 * 8, NA = 8 * 32 * 4, ND = 8 * 32 * 8;
        for (int it = bid_; it < NZ + NA + ND; it += gridDim.x) {
            int r = it;
            if (r < NZ) { const int cb_ = r & 7, tb = (r >> 3) & 31, b = r >> 8; const int t = tb * 64 + tl; const size_t tok = (size_t)b * T + t;
                float cv[2][8];
#pragma unroll
                for (int grp = 0; grp < 2; ++grp) { const int col = grp * 512 + cb_ * 64 + c0l;
                    const u32x4 u1 = *(const u32x4*)(bufB + tok * 1536 + col);
                    u32x4 u0 = {0u, 0u, 0u, 0u}, u2 = {0u, 0u, 0u, 0u};
                    if (t > 0) u0 = *(const u32x4*)(bufB + (tok - 1) * 1536 + col);
                    if (t < T - 1) u2 = *(const u32x4*)(bufB + (tok + 1) * 1536 + col);
                    const f32x4 w0a = *(const f32x4*)(cw + col), w0b = *(const f32x4*)(cw + col + 4), w1a = *(const f32x4*)(cw + 1536 + col), w1b = *(const f32x4*)(cw + 1536 + col + 4);
                    const f32x4 w2a = *(const f32x4*)(cw + 3072 + col), w2b = *(const f32x4*)(cw + 3072 + col + 4), ba = *(const f32x4*)(cb + col), bb = *(const f32x4*)(cb + col + 4);
                    const unsigned p0[4] = {u0.x, u0.y, u0.z, u0.w}, p1[4] = {u1.x, u1.y, u1.z, u1.w}, p2[4] = {u2.x, u2.y, u2.z, u2.w};
#pragma unroll
                    for (int j = 0; j < 4; ++j) { const float wl0 = j < 2 ? w0a[2 * j] : w0b[2 * j - 4], wh0 = j < 2 ? w0a[2 * j + 1] : w0b[2 * j - 3];
                        const float wl1 = j < 2 ? w1a[2 * j] : w1b[2 * j - 4], wh1 = j < 2 ? w1a[2 * j + 1] : w1b[2 * j - 3];
                        const float wl2 = j < 2 ? w2a[2 * j] : w2b[2 * j - 4], wh2 = j < 2 ? w2a[2 * j + 1] : w2b[2 * j - 3];
                        const float bl = j < 2 ? ba[2 * j] : bb[2 * j - 4], bh = j < 2 ? ba[2 * j + 1] : bb[2 * j - 3];
                        cv[grp][2 * j] = wl0 * bflo(p0[j]) + wl1 * bflo(p1[j]) + wl2 * bflo(p2[j]) + bl;
                        cv[grp][2 * j + 1] = wh0 * bfhi(p0[j]) + wh1 * bfhi(p1[j]) + wh2 * bfhi(p2[j]) + bh; } }
#pragma unroll
                for (int j = 0; j < 8; ++j) tile[(c0l + j) * 72 + tl] = f2bf(cv[0][j] * cv[1][j]);
                __syncthreads();
                tr_store(tile, zT, (size_t)(cb_ * 64) * 8 + b, 8, tb * 64);
                __syncthreads(); continue; }
            r -= NZ;
            if (r < NA) { const int cb_ = r & 3, tb = (r >> 2) & 31, b = r >> 7;
                const u32x4 v = *(const u32x4*)(bufA + ((size_t)b * T + tb * 64 + tl) * 1536 + 1280 + cb_ * 64 + c0l);
                const unsigned pv[4] = {v.x, v.y, v.z, v.w};
#pragma unroll
                for (int j = 0; j < 4; ++j) { tile[(c0l + 2 * j) * 72 + tl] = (bf16_t)(pv[j] & 0xffffu); tile[(c0l + 2 * j + 1) * 72 + tl] = (bf16_t)(pv[j] >> 16); }
                __syncthreads();
                tr_store(tile, vta, (size_t)b * 256 + cb_ * 64, 1, tb * 64);
                __syncthreads(); continue; }
            r -= NA;
            { const int cb_ = r & 7, tb = (r >> 3) & 31, b = r >> 8;
                const u32x4 v = *(const u32x4*)(bufD + ((size_t)b * T + tb * 64 + tl) * 1536 + 1024 + cb_ * 64 + c0l);
                const unsigned pv[4] = {v.x, v.y, v.z, v.w};
#pragma unroll
                for (int j = 0; j < 4; ++j) { tile[(c0l + 2 * j) * 72 + tl] = (bf16_t)(pv[j] & 0xffffu); tile[(c0l + 2 * j + 1) * 72 + tl] = (bf16_t)(pv[j] >> 16); }
                __syncthreads();
                tr_store(tile, vtd, (size_t)b * 512 + cb_ * 64, 1, tb * 64);
                __syncthreads(); }
        }
    }
}
__device__ __forceinline__ void scan_item(const Args& a, unsigned char* smem, int l, int item) {
    unsigned char* wsl = launder_ws(a.ws);
    int tid = threadIdx.x; asm volatile("" : "+v"(tid));
    const int dir = item & 1, h = (item >> 1) & 7, b = item >> 4;
    constexpr int BUFSZ = 7 * 1024 + 16;
    float* lds = (float*)smem;
    const bf16_t* bufC = (const bf16_t*)(wsl + OFF_BUFC);
    const bf16_t* sla = (const bf16_t*)(wsl + OFF_SLD) + (size_t)dir * M * 1024;
    bf16_t* oc = (bf16_t*)(wsl + OFF_OCDIR) + (size_t)dir * M * 512;
    const bool is_prod = tid >= 256;
    const int t8 = tid & 255, lane = tid & 63;
    const int pt0 = t8 >> 5, kp = t8 & 31, colr = h * 64 + 2 * kp;
    float w00 = 0.f, w01 = 0.f, a00 = 0.f, a01 = 0.f, mur0 = 0.f, mur1 = 0.f, muk0 = 0.f, muk1 = 0.f, muv0 = 0.f, muv1 = 0.f, kk0 = 0.f, kk1 = 0.f, ka0 = 0.f, ka1 = 0.f, rk0 = 0.f, rk1 = 0.f, lw0 = 0.f, lw1 = 0.f, lb0 = 0.f, lb1 = 0.f;
    if (is_prod) {
        w00 = a.in[17][(l * 2 + dir) * 512 + colr]; w01 = a.in[17][(l * 2 + dir) * 512 + colr + 1];
        a00 = a.in[19][(l * 2 + dir) * 512 + colr]; a01 = a.in[19][(l * 2 + dir) * 512 + colr + 1];
        const float* mu = a.in[16] + (size_t)(l * 2 + dir) * 1728;
        mur0 = mu[colr]; mur1 = mu[colr + 1]; muk0 = mu[512 + colr]; muk1 = mu[512 + colr + 1]; muv0 = mu[1024 + colr]; muv1 = mu[1024 + colr + 1];
        kk0 = a.in[22][l * 512 + colr]; kk1 = a.in[22][l * 512 + colr + 1]; ka0 = a.in[23][l * 512 + colr]; ka1 = a.in[23][l * 512 + colr + 1];
        rk0 = a.in[24][l * 512 + colr]; rk1 = a.in[24][l * 512 + colr + 1];
        lw0 = a.in[25][l * 512 + colr]; lw1 = a.in[25][l * 512 + colr + 1]; lb0 = a.in[26][l * 512 + colr]; lb1 = a.in[26][l * 512 + colr + 1];
    }
    const int cvp = t8 >> 3, ks = t8 & 7;
    typedef float f32x2s __attribute__((ext_vector_type(2)));
    f32x2s S2[8];
#pragma unroll
    for (int j = 0; j < 8; ++j) S2[j] = (f32x2s){0.f, 0.f};
    unsigned xr[2], xk[2], xv[2], sr[2], sk[2], sv[2], xl[2], xa[2];
#define SCAN_LOAD(c) do { _Pragma("unroll") for (int pp = 0; pp < 2; ++pp) { const int s_ = (c) * 16 + pt0 + 8 * pp; const int t_ = dir ? (T - 1 - s_) : s_; const int ts_ = dir ? t_ + 1 : t_ - 1; const size_t tok_ = (size_t)b * T + t_; \
        const bf16_t* p_ = bufC + tok_ * 2048 + colr; xr[pp] = *(const unsigned*)p_; xk[pp] = *(const unsigned*)(p_ + 512); xv[pp] = *(const unsigned*)(p_ + 1024); \
        sr[pp] = 0u; sk[pp] = 0u; sv[pp] = 0u; if (ts_ >= 0 && ts_ < T) { const bf16_t* q_ = bufC + ((size_t)b * T + ts_) * 2048 + colr; sr[pp] = *(const unsigned*)q_; sk[pp] = *(const unsigned*)(q_ + 512); sv[pp] = *(const unsigned*)(q_ + 1024); } \
        xl[pp] = *(const unsigned*)(sla + tok_ * 1024 + colr); xa[pp] = *(const unsigned*)(sla + tok_ * 1024 + 512 + colr); } } while (0)
#define SCAN_PRODUCE(bufp) do { float* R_ = (bufp); float* W_ = R_ + 1024; float* K_ = W_ + 1024; float* A_ = K_ + 1024; float* B_ = A_ + 1024; float* V_ = B_ + 1024; float* SB_ = V_ + 2048; \
        _Pragma("unroll") for (int pp = 0; pp < 2; ++pp) { const int ptl = pt0 + 8 * pp; \
            const float r0 = bflo(xr[pp]) + (bflo(sr[pp]) - bflo(xr[pp])) * mur0, r1 = bfhi(xr[pp]) + (bfhi(sr[pp]) - bfhi(xr[pp])) * mur1; \
            const float k0 = bflo(xk[pp]) + (bflo(sk[pp]) - bflo(xk[pp])) * muk0, k1 = bfhi(xk[pp]) + (bfhi(sk[pp]) - bfhi(xk[pp])) * muk1; \
            const float v0 = bflo(xv[pp]) + (bflo(sv[pp]) - bflo(xv[pp])) * muv0, v1 = bfhi(xv[pp]) + (bfhi(sv[pp]) - bfhi(xv[pp])) * muv1; \
            const float a0 = sigmoidf_(a00 + bflo(xa[pp])), a1 = sigmoidf_(a01 + bfhi(xa[pp])); \
            const float q0 = k0 * kk0, q1 = k1 * kk1; \
            const float ss = half_sum(q0 * q0 + q1 * q1, lane); \
            const float inv = 1.f / fmaxf(sqrtf(ss), 1e-12f); \
            const float n0 = q0 * inv, n1 = q1 * inv; \
            const float kn0 = k0 * (1.f + (a0 - 1.f) * ka0), kn1 = k1 * (1.f + (a1 - 1.f) * ka1); \
            const float sb = half_sum(r0 * kn0 * rk0 + r1 * kn1 * rk1, lane); \
            const int o = ptl * 64 + 2 * kp; \
            *(float2*)(R_ + o) = make_float2(r0, r1); \
            *(float2*)(W_ + o) = make_float2(__expf(-0.60653065971f * sigmoidf_(w00 + bflo(xl[pp]))), __expf(-0.60653065971f * sigmoidf_(w01 + bfhi(xl[pp])))); \
            *(float2*)(K_ + o) = make_float2(kn0, kn1); \
            *(float2*)(A_ + o) = make_float2(-n0, -n1); \
            *(float2*)(B_ + o) = make_float2(n0 * a0, n1 * a1); \
            *(float2*)(V_ + o) = make_float2(v0, v1); \
            if (kp == 0) SB_[ptl] = sb; } } while (0)
    if (is_prod) { SCAN_LOAD(0); SCAN_PRODUCE(lds); SCAN_LOAD(1); }
    __syncthreads();
    for (int c = 0; c < 128; ++c) {
        float* cur = lds + (c & 1) * BUFSZ; float* oth = lds + ((c & 1) ^ 1) * BUFSZ;
        if (!is_prod) {
            const float* R = cur; const float* W = R + 1024; const float* Kx = W + 1024; const float* Ax = Kx + 1024; const float* Bx = Ax + 1024; const float* Vx = Bx + 1024; float* Ox = cur + 6 * 1024;
#define SC_DECL(P) f32x4 P##a0, P##a1, P##w0, P##w1, P##b0, P##b1, P##k0, P##k1, P##r0, P##r1; float2 P##vv
#define SC_LOAD(P, tl) do { P##vv = *(const float2*)(Vx + (tl) * 64 + 2 * cvp); \
                P##a0 = *(const f32x4*)(Ax + (tl) * 64 + ks * 8); P##a1 = *(const f32x4*)(Ax + (tl) * 64 + ks * 8 + 4); \
                P##w0 = *(const f32x4*)(W + (tl) * 64 + ks * 8); P##w1 = *(const f32x4*)(W + (tl) * 64 + ks * 8 + 4); \
                P##b0 = *(const f32x4*)(Bx + (tl) * 64 + ks * 8); P##b1 = *(const f32x4*)(Bx + (tl) * 64 + ks * 8 + 4); \
                P##k0 = *(const f32x4*)(Kx + (tl) * 64 + ks * 8); P##k1 = *(const f32x4*)(Kx + (tl) * 64 + ks * 8 + 4); \
                P##r0 = *(const f32x4*)(R + (tl) * 64 + ks * 8); P##r1 = *(const f32x4*)(R + (tl) * 64 + ks * 8 + 4); } while (0)
#define SC_STEP(P, tl) do { \
                f32x2s sa = (S2[0] * P##a0[0] + S2[1] * P##a0[1]) + (S2[2] * P##a0[2] + S2[3] * P##a0[3]); \
                f32x2s sb_ = (S2[4] * P##a1[0] + S2[5] * P##a1[1]) + (S2[6] * P##a1[2] + S2[7] * P##a1[3]); \
                sa = sa + sb_; \
                sa.x = sum8(sa.x); sa.y = sum8(sa.y); \
                const f32x2s vv2 = {P##vv.x, P##vv.y}; \
                _Pragma("unroll") for (int j = 0; j < 4; ++j) { \
                    S2[j] = S2[j] * P##w0[j] + (sa * P##b0[j] + vv2 * P##k0[j]); S2[4 + j] = S2[4 + j] * P##w1[j] + (sa * P##b1[j] + vv2 * P##k1[j]); } \
                f32x2s oo = (S2[0] * P##r0[0] + S2[1] * P##r0[1]) + (S2[2] * P##r0[2] + S2[3] * P##r0[3]); \
                f32x2s ob_ = (S2[4] * P##r1[0] + S2[5] * P##r1[1]) + (S2[6] * P##r1[2] + S2[7] * P##r1[3]); \
                oo = oo + ob_; \
                oo.x = sum8(oo.x); oo.y = sum8(oo.y); \
                if (ks == 0) *(float2*)(Ox + (tl) * 64 + 2 * cvp) = make_float2(oo.x, oo.y); } while (0)
            SC_DECL(pa_); SC_DECL(pb_);
            SC_LOAD(pa_, 0);
#pragma unroll 1
            for (int tl = 0; tl < 16; tl += 2) {
                SC_LOAD(pb_, tl + 1);
                SC_STEP(pa_, tl);
                if (tl + 2 < 16) SC_LOAD(pa_, tl + 2);
                SC_STEP(pb_, tl + 1);
            }
#undef SC_DECL
#undef SC_LOAD
#undef SC_STEP
        } else {
            if (c > 0) {
                const float* Ox = oth + 6 * 1024; const float* Vx = oth + 5 * 1024; const float* SB = oth + 7 * 1024;
#pragma unroll
                for (int pp = 0; pp < 2; ++pp) { const int ptl = pt0 + 8 * pp;
                    const float2 ov = *(const float2*)(Ox + ptl * 64 + 2 * kp);
                    const float mean = half_sum(ov.x + ov.y, lane) * (1.f / 64.f);
                    const float d0 = ov.x - mean, d1 = ov.y - mean;
                    const float var = half_sum(d0 * d0 + d1 * d1, lane) * (1.f / 64.f);
                    const float rs = rsqrtf(var + 64e-5f);
                    const float2 vv = *(const float2*)(Vx + ptl * 64 + 2 * kp); const float sb = SB[ptl];
                    const float y0 = d0 * rs * lw0 + lb0 + sb * vv.x, y1 = d1 * rs * lw1 + lb1 + sb * vv.y;
                    const int s_ = (c - 1) * 16 + ptl; const int t_ = dir ? (T - 1 - s_) : s_;
                    *(unsigned*)(oc + ((size_t)b * T + t_) * 512 + colr) = pk2(y0, y1); }
            }
            if (c + 1 < 128) { SCAN_PRODUCE(oth); if (c + 2 < 128) SCAN_LOAD(c + 2); }
        }
        __syncthreads();
    }
    if (is_prod) {
        const float* fin = lds + (127 & 1) * BUFSZ; const float* Ox = fin + 6 * 1024; const float* Vx = fin + 5 * 1024; const float* SB = fin + 7 * 1024;
#pragma unroll
        for (int pp = 0; pp < 2; ++pp) { const int ptl = pt0 + 8 * pp;
            const float2 ov = *(const float2*)(Ox + ptl * 64 + 2 * kp);
            const float mean = half_sum(ov.x + ov.y, lane) * (1.f / 64.f);
            const float d0 = ov.x - mean, d1 = ov.y - mean;
            const float var = half_sum(d0 * d0 + d1 * d1, lane) * (1.f / 64.f);
            const float rs = rsqrtf(var + 64e-5f);
            const float2 vv = *(const float2*)(Vx + ptl * 64 + 2 * kp); const float sb = SB[ptl];
            const float y0 = d0 * rs * lw0 + lb0 + sb * vv.x, y1 = d1 * rs * lw1 + lb1 + sb * vv.y;
            const int s_ = 127 * 16 + ptl; const int t_ = dir ? (T - 1 - s_) : s_;
            *(unsigned*)(oc + ((size_t)b * T + t_) * 512 + colr) = pk2(y0, y1); }
    }
    __syncthreads();
#undef SCAN_LOAD
#undef SCAN_PRODUCE
}
template <int DQK, int MODE>
__device__ __forceinline__ void attn_item(unsigned char* smem, const bf16_t* Q, int ldq, const bf16_t* Kg, int ldk, const bf16_t* Vt, float sc, float slope, int q0,
                                          bf16_t* O, int ldo, float lam, const float* subln, float outmul) {
    constexpr int KST = DQK * 2 + 16, VST = 144, KBYTES = 64 * KST, VBYTES = 128 * VST, NKK = DQK / 16, KCH = DQK / 8, KLD = KCH / 8;
    int tid = threadIdx.x; asm volatile("" : "+v"(tid));
    const int lane = tid & 63, wave = tid >> 6, r = lane & 31, h = lane >> 5;
#define Kb_(x) (smem + (x) * KBYTES)
#define Vb_(x) (smem + 2 * KBYTES + (x) * VBYTES)
    bf16x8 qf[NKK];
    { const bf16_t* qp = Q + (size_t)(wave * 32 + r) * ldq + 8 * h;
#pragma unroll
      for (int kk = 0; kk < NKK; ++kk) { const u32x4 qv = *(const u32x4*)(qp + 16 * kk); u32x4 w;
          w.x = pk2(bflo(qv.x) * sc, bfhi(qv.x) * sc); w.y = pk2(bflo(qv.y) * sc, bfhi(qv.y) * sc); w.z = pk2(bflo(qv.z) * sc, bfhi(qv.z) * sc); w.w = pk2(bflo(qv.w) * sc, bfhi(qv.w) * sc);
          qf[kk] = __builtin_bit_cast(bf16x8, w); } }
    f32x16 o[4];
#pragma unroll
    for (int i = 0; i < 4; ++i)
#pragma unroll
        for (int j = 0; j < 16; ++j) o[i][j] = 0.f;
    float m_run = -1e30f, l_run = 0.f;
    u32x4 kreg[2];
#define ATT_LOADK(kt) do { _Pragma("unroll") for (int i_ = 0; i_ < KLD; ++i_) { const int id_ = tid + 512 * i_, row_ = id_ / KCH, ch_ = id_ % KCH; kreg[i_] = *(const u32x4*)(Kg + (size_t)((kt) * 64 + row_) * ldk + ch_ * 8); } } while (0)
#define ATT_LOADV(kt) do { _Pragma("unroll") for (int i_ = 0; i_ < 2; ++i_) { const int id_ = tid + 512 * i_, row_ = id_ >> 3, ch_ = id_ & 7; kreg[i_] = *(const u32x4*)(Vt + (size_t)row_ * T + (kt) * 64 + ch_ * 8); } } while (0)
#define ATT_STOREK(bi) do { _Pragma("unroll") for (int i_ = 0; i_ < KLD; ++i_) { const int id_ = tid + 512 * i_, row_ = id_ / KCH, ch_ = id_ % KCH; *(u32x4*)(Kb_(bi) + row_ * KST + ch_ * 16) = kreg[i_]; } } while (0)
#define ATT_STOREV(bi) do { _Pragma("unroll") for (int i_ = 0; i_ < 2; ++i_) { const int id_ = tid + 512 * i_, row_ = id_ >> 3, ch_ = id_ & 7; *(u32x4*)(Vb_(bi) + row_ * VST + ch_ * 16) = kreg[i_]; } } while (0)
    __syncthreads();
    ATT_LOADK(0); ATT_STOREK(0); ATT_LOADV(0); ATT_STOREV(0);
    __syncthreads();
    const int qpos = q0 + wave * 32 + r;
    for (int kt = 0; kt < 32; ++kt) {
        const int bi = kt & 1;
#pragma unroll
        for (int kb = 0; kb < 2; ++kb) {
            if (kt + 1 < 32) { if (kb == 0) ATT_LOADK(kt + 1); else { ATT_STOREK(bi ^ 1); ATT_LOADV(kt + 1); } }
            f32x16 s;
#pragma unroll
            for (int j = 0; j < 16; ++j) s[j] = 0.f;
#pragma unroll
            for (int kk = 0; kk < NKK; ++kk) { const bf16x8 af = *(const bf16x8*)(Kb_(bi) + (32 * kb + r) * KST + (16 * kk + 8 * h) * 2);
                s = __builtin_amdgcn_mfma_f32_32x32x16_bf16(af, qf[kk], s, 0, 0, 0); }
            float mt = -1e30f;
            if (slope != 0.f) { const float dq = (float)(qpos - kt * 64 - 4 * h - 32 * kb);
#pragma unroll
                for (int j = 0; j < 16; ++j) { const float dd = dq - (float)((j & 3) + 8 * (j >> 2)); s[j] = fmaf(-slope, fabsf(dd), s[j]); mt = fmaxf(mt, s[j]); }
            } else {
#pragma unroll
                for (int j = 0; j < 16; ++j) mt = fmaxf(mt, s[j]);
            }
            mt = fmaxf(mt, shx(mt, 32, lane));
            const float m_new = fmaxf(m_run, mt), alpha = __builtin_amdgcn_exp2f(m_run - m_new);
            m_run = m_new;
            float psum = 0.f;
#pragma unroll
            for (int j = 0; j < 16; ++j) { s[j] = __builtin_amdgcn_exp2f(s[j] - m_new); psum += s[j]; }
            l_run = l_run * alpha + psum;
            if (__builtin_amdgcn_ballot_w64(alpha != 1.0f) != 0ull) {
#pragma unroll
                for (int i = 0; i < 4; ++i) o[i] = o[i] * alpha; }
            bf16x8 pf[2];
#pragma unroll
            for (int s2 = 0; s2 < 2; ++s2) { u32x4 w; w.x = pk2(s[8 * s2 + 0], s[8 * s2 + 1]); w.y = pk2(s[8 * s2 + 2], s[8 * s2 + 3]);
                w.z = pk2(s[8 * s2 + 4], s[8 * s2 + 5]); w.w = pk2(s[8 * s2 + 6], s[8 * s2 + 7]); pf[s2] = __builtin_bit_cast(bf16x8, w); }
#pragma unroll
            for (int dvb = 0; dvb < 4; ++dvb)
#pragma unroll
                for (int s2 = 0; s2 < 2; ++s2) { const unsigned char* vp = Vb_(bi) + (32 * dvb + r) * VST + (32 * kb + 16 * s2 + 4 * h) * 2;
                    const u32x2 lo = *(const u32x2*)vp, hi = *(const u32x2*)(vp + 16); u32x4 w; w.x = lo.x; w.y = lo.y; w.z = hi.x; w.w = hi.y;
                    o[dvb] = __builtin_amdgcn_mfma_f32_32x32x16_bf16(__builtin_bit_cast(bf16x8, w), pf[s2], o[dvb], 0, 0, 0); }
        }
        if (kt + 1 < 32) ATT_STOREV(bi ^ 1);
        __syncthreads();
    }
#undef ATT_LOADK
#undef ATT_LOADV
#undef ATT_STOREK
#undef ATT_STOREV
#undef Kb_
#undef Vb_
    const float lt = l_run + shx(l_run, 32, lane), inv = 1.f / lt;
    bf16_t* orow = O + (size_t)(wave * 32 + r) * ldo;
    unsigned char* stash = smem + 73728 + tid * 128;
    if (MODE == 0) {
#pragma unroll
        for (int dvb = 0; dvb < 4; ++dvb)
#pragma unroll
            for (int g = 0; g < 4; ++g) { u32x2 w; w.x = pk2(o[dvb][4 * g] * inv, o[dvb][4 * g + 1] * inv); w.y = pk2(o[dvb][4 * g + 2] * inv, o[dvb][4 * g + 3] * inv);
                *(u32x2*)(orow + 32 * dvb + 8 * g + 4 * h) = w; }
    } else if (MODE == 1) {
#pragma unroll
        for (int dvb = 0; dvb < 4; ++dvb)
#pragma unroll
            for (int g = 0; g < 4; ++g) { u32x2 w; w.x = pk2(o[dvb][4 * g] * inv, o[dvb][4 * g + 1] * inv); w.y = pk2(o[dvb][4 * g + 2] * inv, o[dvb][4 * g + 3] * inv);
                *(u32x2*)(stash + (4 * dvb + g) * 8) = w; }
    } else {
        float ss = 0.f;
#pragma unroll
        for (int dvb = 0; dvb < 4; ++dvb)
#pragma unroll
            for (int g = 0; g < 4; ++g) { const u32x2 pv = *(const u32x2*)(stash + (4 * dvb + g) * 8);
                o[dvb][4 * g] = bflo(pv.x) - lam * o[dvb][4 * g] * inv; o[dvb][4 * g + 1] = bfhi(pv.x) - lam * o[dvb][4 * g + 1] * inv;
                o[dvb][4 * g + 2] = bflo(pv.y) - lam * o[dvb][4 * g + 2] * inv; o[dvb][4 * g + 3] = bfhi(pv.y) - lam * o[dvb][4 * g + 3] * inv;
#pragma unroll
                for (int j = 0; j < 4; ++j) ss += o[dvb][4 * g + j] * o[dvb][4 * g + j]; }
        ss += shx(ss, 32, lane);
        const float rs = rsqrtf(ss * (1.f / 128.f) + 1e-6f) * outmul;
#pragma unroll
        for (int dvb = 0; dvb < 4; ++dvb)
#pragma unroll
            for (int g = 0; g < 4; ++g) { const f32x4 gv = *(const f32x4*)(subln + 32 * dvb + 8 * g + 4 * h); u32x2 w;
                w.x = pk2(o[dvb][4 * g] * rs * gv[0], o[dvb][4 * g + 1] * rs * gv[1]); w.y = pk2(o[dvb][4 * g + 2] * rs * gv[2], o[dvb][4 * g + 3] * rs * gv[3]);
                *(u32x2*)(orow + 32 * dvb + 8 * g + 4 * h) = w; }
    }
}
__device__ __forceinline__ void hyena_item(const Args& a, unsigned char* smem, int l, int c) {
    unsigned char* wsl = launder_ws(a.ws);
    constexpr int CST = 4112;
    int tid = threadIdx.x; asm volatile("" : "+v"(tid));
    const int lane = tid & 63, wave = tid >> 6;
    float* HF = (float*)smem; float* HB = HF + 2048; float* red = HB + 2048;
    float* w4s = red + 16;
    bf16_t* E = (bf16_t*)(smem + 16384 + 1024);
    bf16_t* zs = E + 8 * CST;
    constexpr int ZST = 2056;
    const float* hid3 = (const float*)(wsl + OFF_HID3) + (size_t)l * 2048 * 64;
    const float* w4 = a.in[13] + (size_t)l * 64 * 1024;
    __syncthreads();
    if (tid < 128) w4s[tid] = w4[(tid & 63) * 1024 + (tid >> 6) * 512 + c];
    __syncthreads();
    const float delta = fabsf(-3.0701134573253946f + (-15.350567286626972f + 3.0701134573253946f) * ((float)c / 511.f));
    float asum = 0.f;
#pragma unroll 1
    for (int rr = 0; rr < 4; ++rr) { const int j = tid + 512 * rr; const f32x4* hp = (const f32x4*)(hid3 + (size_t)j * 64);
        float f = 0.f, bk = 0.f;
#pragma unroll
        for (int q = 0; q < 16; ++q) { const f32x4 hv = hp[q];
#pragma unroll
            for (int e = 0; e < 4; ++e) { f += hv[e] * w4s[4 * q + e]; bk += hv[e] * w4s[64 + 4 * q + e]; } }
        const float win = __expf(-((float)j / 2047.f) * delta);
        f *= win; bk *= win; HF[j] = f; HB[j] = bk; asum += fabsf(f) + (j > 0 ? fabsf(bk) : 0.f); }
    asum = wave_sum(asum, lane);
    if (lane == 0) red[wave] = asum;
    { const bf16_t* zT = (const bf16_t*)(wsl + OFF_ZT) + (size_t)c * 8 * 2048;
#pragma unroll
      for (int i = 0; i < 4; ++i) { const int id = tid + 512 * i, bb = id >> 8, ch = id & 255; *(u32x4*)(zs + bb * ZST + ch * 8) = *(const u32x4*)(zT + (size_t)bb * 2048 + ch * 8); } }
    __syncthreads();
    float tot = 0.f;
#pragma unroll
    for (int i = 0; i < 8; ++i) tot += red[i];
    const float invn = 1.f / tot;
    for (int idx = tid; idx < 8 * 4096; idx += NTHR) { const int u = idx >> 12, ip = idx & 4095, i = ip - u; float v = 0.f;
        if (i >= 1 && i <= 4095) { const int d = 2048 - i; v = (d >= 0 ? HF[d] : HB[-d]) * invn; }
        E[u * CST + ip] = f2bf(v); }
    __syncthreads();
    float* yT = (float*)(wsl + OFF_YT) + (size_t)c * 8 * 2048;
    const int m = lane & 15, q = lane >> 4;
    const bf16_t* Eu = E + (m & 7) * CST + 2048 + 8 * q - (m & 8);
    const bf16_t* zrow = zs + (m & 7) * ZST + 8 * q;
#pragma unroll 1
    for (int g = 0; g < 4; ++g) {
        const int tt0 = wave * 16 + g * 4;
        f32x4 acc[4];
#pragma unroll
        for (int i = 0; i < 4; ++i) acc[i] = (f32x4){0.f, 0.f, 0.f, 0.f};
#pragma unroll 2
        for (int ss = 0; ss < 64; ++ss) { const int s0 = ss * 32;
            bf16x8 bz = *(const bf16x8*)(zrow + s0);
            if (m >= 8) bz = (bf16x8){0, 0, 0, 0, 0, 0, 0, 0};
#pragma unroll
            for (int i = 0; i < 4; ++i) { const bf16x8 af = *(const bf16x8*)(Eu - (tt0 + i) * 16 + s0);
                acc[i] = __builtin_amdgcn_mfma_f32_16x16x32_bf16(af, bz, acc[i], 0, 0, 0); } }
        if (m < 8) {
#pragma unroll
            for (int i = 0; i < 4; ++i) *(f32x4*)(yT + (size_t)m * 2048 + (tt0 + i) * 16 + 4 * q) = acc[i]; }
    }
    __syncthreads();
}
#if defined(DBG_STOP)
#ifndef PH_MASK
#define PH_MASK ((2 << (DBG_STOP >= 40 ? 4 : DBG_STOP)) - 1)
#endif
#define DBG_LAYERS 1
#ifndef DBG_NL
#define DBG_NL 1
#endif
#define NLAYER DBG_NL
#else
#define NLAYER 2
#endif
#ifndef PH_MASK
#define PH_MASK 0xFFF
#endif
#ifndef PH_MASK0
#define PH_MASK0 0xFFF
#endif
#ifndef PH_DUP
#define PH_DUP 0
#endif
__device__ __forceinline__ void mixers_phase(const Args& a, unsigned char* smem, int l) {
    unsigned char* wsl = launder_ws(a.ws); const int bid_ = lbid();
    constexpr int N_SCAN = 128, N_D = 256, N_A = 512, N_H = 512, N_W8 = 44 * 32 + 8 * 88, N_W0 = 32 * 32 + 8 * 16 + 3 * 8 * 8 + 8 * 32, N_ALL = N_SCAN + 4 * (N_D + N_A + N_H);
    static_assert(3 * (N_D + N_A + N_H) >= N_W8 + N_W0, "memory item slots");
    unsigned* ctr = (unsigned*)(wsl + OFF_CTL) + 64 * (1 + l);
    int* sh = (int*)(smem + LDS_BYTES - 16);
    const float LOG2E = 1.4426950408889634f;
    for (;;) {
        __syncthreads();
        if (ltid() == 0) sh[0] = (int)atomicAdd(ctr, 1u);
        __syncthreads();
        const int it = __builtin_amdgcn_readfirstlane(sh[0]);
        if (it >= N_ALL) break;
        if (it < N_SCAN) { scan_item(a, smem, l, it); continue; }
        const int q = it - N_SCAN, grp = q >> 2, j = q & 3;
        if (j < 3) {
            const int m = grp * 3 + j;
            if (m >= N_W8 + N_W0) continue;
            const WItem w = m < N_W8 ? witem_phase8(wsl, m) : witem_phase0(wsl, 26 * 32 + (m - N_W8)); float rg[32];
            witem_load(a, l, w, rg); witem_tolds((float*)smem, rg);
            __syncthreads();
            witem_store(w, (const float*)smem);
            continue;
        }
        int r = grp;
        if (r < N_D) {
            const int qb = r & 7, hd = (r >> 3) & 3, b = r >> 5;
            const bf16_t* bufD = (const bf16_t*)(wsl + OFF_BUFD) + (size_t)b * T * 1536;
            const bf16_t* vt = (const bf16_t*)(wsl + OFF_VTD) + ((size_t)b * 512 + hd * 128) * T;
            bf16_t* od = (bf16_t*)(wsl + OFF_OD) + ((size_t)b * T + qb * 256) * 512 + hd * 128;
            const float slope = exp2f(-2.f * (float)(hd + 1)) * LOG2E, sc = 0.125f * LOG2E;
            const float lam = ((const float*)(wsl + OFF_LAM))[l];
            const float lam_init = 0.8f - 0.6f * expf(-0.3f * (float)l);
            attn_item<64, 1>(smem, bufD + (size_t)qb * 256 * 1536 + hd * 128, 1536, bufD + 512 + hd * 128, 1536, vt, sc, slope, qb * 256, od, 512, 0.f, nullptr, 1.f);
            attn_item<64, 2>(smem, bufD + (size_t)qb * 256 * 1536 + hd * 128 + 64, 1536, bufD + 512 + hd * 128 + 64, 1536, vt, sc, slope, qb * 256, od, 512, lam, a.in[31] + l * 128, 1.f - lam_init);
            continue; }
        r -= N_D;
        if (r < N_A) {
            const int qb = r & 7, hq = (r >> 3) & 7, b = r >> 6, hkv = hq >> 2;
            const bf16_t* bufA = (const bf16_t*)(wsl + OFF_BUFA) + (size_t)b * T * 1536;
            const bf16_t* vt = (const bf16_t*)(wsl + OFF_VTA) + ((size_t)b * 256 + hkv * 128) * T;
            bf16_t* oa = (bf16_t*)(wsl + OFF_OA) + ((size_t)b * T + qb * 256) * 1024 + hq * 128;
            attn_item<128, 0>(smem, bufA + (size_t)qb * 256 * 1536 + hq * 128, 1536, bufA + 1024 + hkv * 128, 1536, vt, 0.08838834764831845f * LOG2E, 0.f, qb * 256, oa, 1024, 0.f, nullptr, 1.f);
            continue; }
        r -= N_A;
        hyena_item(a, smem, l, r);
    }
}
__device__ __forceinline__ void post_phase(const Args& a, unsigned char* smem, int l) {
    unsigned char* wsl = launder_ws(a.ws); const int bid_ = lbid();
    const int tid = ltid();
    const bf16_t* bufB = (const bf16_t*)(wsl + OFF_BUFB);
    const float* yT = (const float*)(wsl + OFF_YT);
    bf16_t* ob = (bf16_t*)(wsl + OFF_OB);
    const float* cw = a.in[5] + (size_t)l * 3 * 1536; const float* cb = a.in[6] + (size_t)l * 1536; const float* skip = a.in[15] + l * 512;
    float* Y = (float*)smem;
    for (int it = bid_; it < 8 * 32 * 8; it += gridDim.x) {
        const int cb_ = it & 7, tb = (it >> 3) & 31, b = it >> 8;
        { const int cl = tid >> 3, tch = tid & 7; const float* yp = yT + ((size_t)(cb_ * 64 + cl) * 8 + b) * 2048 + tb * 64 + tch * 8;
          const f32x4 y0 = *(const f32x4*)yp, y1 = *(const f32x4*)(yp + 4); float* d = Y + cl * 65 + tch * 8;
          d[0] = y0[0]; d[1] = y0[1]; d[2] = y0[2]; d[3] = y0[3]; d[4] = y1[0]; d[5] = y1[1]; d[6] = y1[2]; d[7] = y1[3]; }
        __syncthreads();
        {
            const int tl = tid >> 3, c0 = cb_ * 64 + (tid & 7) * 8, t = tb * 64 + tl; const size_t tok = (size_t)b * T + t;
            float cv[3][8];
#pragma unroll
            for (int grp = 0; grp < 3; ++grp) { const int col = grp * 512 + c0;
                const u32x4 u1 = *(const u32x4*)(bufB + tok * 1536 + col);
                u32x4 u0 = {0u, 0u, 0u, 0u}, u2 = {0u, 0u, 0u, 0u};
                if (t > 0) u0 = *(const u32x4*)(bufB + (tok - 1) * 1536 + col);
                if (t < T - 1) u2 = *(const u32x4*)(bufB + (tok + 1) * 1536 + col);
                const f32x4 w0a = *(const f32x4*)(cw + col), w0b = *(const f32x4*)(cw + col + 4), w1a = *(const f32x4*)(cw + 1536 + col), w1b = *(const f32x4*)(cw + 1536 + col + 4);
                const f32x4 w2a = *(const f32x4*)(cw + 3072 + col), w2b = *(const f32x4*)(cw + 3072 + col + 4), ba = *(const f32x4*)(cb + col), bb = *(const f32x4*)(cb + col + 4);
                const unsigned p0[4] = {u0.x, u0.y, u0.z, u0.w}, p1[4] = {u1.x, u1.y, u1.z, u1.w}, p2[4] = {u2.x, u2.y, u2.z, u2.w};
#pragma unroll
                for (int j = 0; j < 4; ++j) { const float wl0 = j < 2 ? w0a[2 * j] : w0b[2 * j - 4], wh0 = j < 2 ? w0a[2 * j + 1] : w0b[2 * j - 3];
                    const float wl1 = j < 2 ? w1a[2 * j] : w1b[2 * j - 4], wh1 = j < 2 ? w1a[2 * j + 1] : w1b[2 * j - 3];
                    const float wl2 = j < 2 ? w2a[2 * j] : w2b[2 * j - 4], wh2 = j < 2 ? w2a[2 * j + 1] : w2b[2 * j - 3];
                    const float bl = j < 2 ? ba[2 * j] : bb[2 * j - 4], bh = j < 2 ? ba[2 * j + 1] : bb[2 * j - 3];
                    cv[grp][2 * j] = wl0 * bflo(p0[j]) + wl1 * bflo(p1[j]) + wl2 * bflo(p2[j]) + bl;
                    cv[grp][2 * j + 1] = wh0 * bfhi(p0[j]) + wh1 * bfhi(p1[j]) + wh2 * bfhi(p2[j]) + bh; } }
            const f32x4 ska = *(const f32x4*)(skip + c0), skb = *(const f32x4*)(skip + c0 + 4);
            float o8[8];
#pragma unroll
            for (int j = 0; j < 8; ++j) { const float z = cv[0][j] * cv[1][j], sk = j < 4 ? ska[j] : skb[j - 4];
                o8[j] = (Y[((tid & 7) * 8 + j) * 65 + tl] + z * sk) * cv[2][j]; }
            u32x4 w; w.x = pk2(o8[0], o8[1]); w.y = pk2(o8[2], o8[3]); w.z = pk2(o8[4], o8[5]); w.w = pk2(o8[6], o8[7]);
            *(u32x4*)(ob + tok * 512 + c0) = w; }
        __syncthreads();
    }
    const bf16_t* oc0 = (const bf16_t*)(wsl + OFF_OCDIR); const bf16_t* oc1 = oc0 + (size_t)M * 512; const bf16_t* gb = (const bf16_t*)(wsl + OFF_GBUF);
    bf16_t* ocv = (bf16_t*)(wsl + OFF_OC);
    for (size_t i = (size_t)bid_ * NTHR + tid; i < (size_t)M * 512 / 8; i += (size_t)gridDim.x * NTHR) {
        const u32x4 x0 = *(const u32x4*)(oc0 + i * 8), x1 = *(const u32x4*)(oc1 + i * 8), g = *(const u32x4*)(gb + i * 8); u32x4 o;
        o.x = pk2((bflo(x0.x) + bflo(x1.x)) * bflo(g.x), (bfhi(x0.x) + bfhi(x1.x)) * bfhi(g.x));
        o.y = pk2((bflo(x0.y) + bflo(x1.y)) * bflo(g.y), (bfhi(x0.y) + bfhi(x1.y)) * bfhi(g.y));
        o.z = pk2((bflo(x0.z) + bflo(x1.z)) * bflo(g.z), (bfhi(x0.z) + bfhi(x1.z)) * bfhi(g.z));
        o.w = pk2((bflo(x0.w) + bflo(x1.w)) * bflo(g.w), (bfhi(x0.w) + bfhi(x1.w)) * bfhi(g.w));
        *(u32x4*)(ocv + i * 8) = o; }
}

#if defined(DBG_STOP)
__device__ __forceinline__ void dbg_dump(const Args& a, const bf16_t* b0, size_t n0, const bf16_t* b1, size_t n1, const bf16_t* b2, size_t n2, const bf16_t* b3, size_t n3) {
    for (size_t i = (size_t)lbid() * NTHR + ltid(); i < (size_t)M * D; i += (size_t)gridDim.x * NTHR)
    {   float v0 = bf2f(b0[i % n0]), v1 = bf2f(b1[i % n1]), v2 = bf2f(b2[i % n2]), v3 = DBG_STOP == 41 ? ((const float*)b3)[i % (n3 / 2)] : bf2f(b3[i % n3]);
        const bool bad = !(fabsf(v0) < 1e30f) || !(fabsf(v1) < 1e30f) || !(fabsf(v2) < 1e30f) || !(fabsf(v3) < 1e30f);
        a.out[i] = bad ? 1e9f : (v0 + v1 + v2 + v3) * 1e-3f; }
}
#define DBG_AT(k, B0, N0, B1, N1, B2, N2, B3, N3) if (DBG_STOP == (k)) { dbg_dump(a, (const bf16_t*)(ws + (B0)), (size_t)(N0), (const bf16_t*)(ws + (B1)), (size_t)(N1), (const bf16_t*)(ws + (B2)), (size_t)(N2), (const bf16_t*)(ws + (B3)), (size_t)(N3)); }
#else
#define DBG_AT(k, B0, N0, B1, N1, B2, N2, B3, N3)
#endif
#define PHASE_SYNC() do { xcd_barrier(xb); ws = launder_ws(a.ws); hbuf = (bf16_t*)(ws + OFF_H); } while (0)
template <int L> __device__ __forceinline__ void run_layer(const Args& a, unsigned char* smem, const XcdBarrier& xb) {
    constexpr int l = L;
    unsigned char* ws = launder_ws(a.ws);
    bf16_t* hbuf = (bf16_t*)(ws + OFF_H);
        ws = launder_ws(a.ws); hbuf = (bf16_t*)(ws + OFF_H);
#if defined(DBG_DELAY)
        if (l == 1) { for (int i = 0; i < 20000; ++i) __builtin_amdgcn_s_sleep(64); PHASE_SYNC(); }
#endif
        for (int rep_ = 0; rep_ < (((PH_DUP >> 0) & 1) ? 2 : 1); ++rep_) if (((l + 1 < NLAYER) ? PH_MASK0 : PH_MASK) & (1 << 0)) {
        if (rep_ > 0) { PHASE_SYNC(); }
        if (lbid() == 0 && ltid() == 0) ((unsigned*)(ws + OFF_CTL))[64 * (1 + l)] = 0u;
        wconv_phase0(a, smem, l);
        if (l == 0) hid3_and_lam(a);
        rmsnorm_rows<true>(l == 0 ? a.in[0] : a.out, a.in[1] + l * 2048, hbuf, nullptr);
        }
        PHASE_SYNC();
        for (int rep_ = 0; rep_ < (((PH_DUP >> 1) & 1) ? 2 : 1); ++rep_) if (((l + 1 < NLAYER) ? PH_MASK0 : PH_MASK) & (1 << 1)) {
        if (rep_ > 0) { PHASE_SYNC(); }
        { EpiIn e; e.bA = (bf16_t*)(ws + OFF_BUFA); e.bB = (bf16_t*)(ws + OFF_BUFB); e.bD = (bf16_t*)(ws + OFF_BUFD); e.bC = (bf16_t*)(ws + OFF_BUFC);
          run_gemm(smem, hbuf, (const bf16_t*)(ws + OFF_WIN), DINP, 2048, e); }
        }
        PHASE_SYNC();
        for (int rep_ = 0; rep_ < (((PH_DUP >> 2) & 1) ? 2 : 1); ++rep_) if (((l + 1 < NLAYER) ? PH_MASK0 : PH_MASK) & (1 << 2)) {
        if (rep_ > 0) { PHASE_SYNC(); }
        prep_phase(a, smem, l);
        }
        PHASE_SYNC();
        for (int rep_ = 0; rep_ < (((PH_DUP >> 3) & 1) ? 2 : 1); ++rep_) if (((l + 1 < NLAYER) ? PH_MASK0 : PH_MASK) & (1 << 3)) {
        if (rep_ > 0) { PHASE_SYNC(); }
#pragma unroll 1
        for (int d = 0; d < 2; ++d) { EpiBf e; e.O = (bf16_t*)(ws + OFF_SLD) + (size_t)d * M * 1024; e.ldc = 1024; e.coff = 0;
            run_gemm(smem, (const bf16_t*)(ws + OFF_ALO) + (size_t)d * M * 256, (const bf16_t*)(ws + OFF_WLORA) + (size_t)d * 1024 * 256, 1024, 256, e); }
        { EpiBf e; e.O = (bf16_t*)(ws + OFF_GBUF); e.ldc = 512; e.coff = 0;
          run_gemm(smem, (const bf16_t*)(ws + OFF_AG), (const bf16_t*)(ws + OFF_WGUP), 512, 256, e); }
        }
        PHASE_SYNC();
        for (int rep_ = 0; rep_ < (((PH_DUP >> 4) & 1) ? 2 : 1); ++rep_) if (((l + 1 < NLAYER) ? PH_MASK0 : PH_MASK) & (1 << 4)) {
        if (rep_ > 0) { PHASE_SYNC(); }
        if (rep_ > 0) { if (lbid() == 0 && ltid() == 0) ((unsigned*)(ws + OFF_CTL))[64 * (1 + l)] = 0u; PHASE_SYNC(); }
        mixers_phase(a, smem, l);
        }
        PHASE_SYNC();
        for (int rep_ = 0; rep_ < (((PH_DUP >> 5) & 1) ? 2 : 1); ++rep_) if (((l + 1 < NLAYER) ? PH_MASK0 : PH_MASK) & (1 << 5)) {
        if (rep_ > 0) { PHASE_SYNC(); }
        post_phase(a, smem, l);
        }
        PHASE_SYNC();
        for (int rep_ = 0; rep_ < (((PH_DUP >> 6) & 1) ? 2 : 1); ++rep_) if (((l + 1 < NLAYER) ? PH_MASK0 : PH_MASK) & (1 << 6)) {
        if (rep_ > 0) { PHASE_SYNC(); }
#pragma unroll 1
        for (int g = 0; g < 4; ++g) { EpiBf e; e.O = (bf16_t*)(ws + OFF_P); e.ldc = 8192; e.coff = g * 2048;
            const bf16_t* A = g == 0 ? (const bf16_t*)(ws + OFF_OA) : (g == 1 ? (const bf16_t*)(ws + OFF_OB) : (g == 2 ? (const bf16_t*)(ws + OFF_OC) : (const bf16_t*)(ws + OFF_OD)));
            const bf16_t* Bt = (const bf16_t*)(ws + OFF_WBR) + (g == 0 ? (size_t)0 : (size_t)2048 * 1024 + (size_t)(g - 1) * 2048 * 512);
            run_gemm(smem, A, Bt, 2048, g == 0 ? 1024 : 512, e); }
        }
        PHASE_SYNC();
        for (int rep_ = 0; rep_ < (((PH_DUP >> 7) & 1) ? 2 : 1); ++rep_) if (((l + 1 < NLAYER) ? PH_MASK0 : PH_MASK) & (1 << 7)) {
        if (rep_ > 0) { PHASE_SYNC(); }
        { EpiGate e; e.P = (const bf16_t*)(ws + OFF_P); e.Mg = (bf16_t*)(ws + OFF_MERGED);
          run_gemm(smem, hbuf, (const bf16_t*)(ws + OFF_WG), 8192, 2048, e); }
        }
        PHASE_SYNC();
        for (int rep_ = 0; rep_ < (((PH_DUP >> 8) & 1) ? 2 : 1); ++rep_) if (((l + 1 < NLAYER) ? PH_MASK0 : PH_MASK) & (1 << 8)) {
        if (rep_ > 0) { PHASE_SYNC(); }
        { EpiRes e; e.base = l == 0 ? a.in[0] : a.out; e.out = a.out;
          run_gemm(smem, (const bf16_t*)(ws + OFF_MERGED), (const bf16_t*)(ws + OFF_WO), 2048, 2048, e); }
        }
        PHASE_SYNC();
        for (int rep_ = 0; rep_ < (((PH_DUP >> 9) & 1) ? 2 : 1); ++rep_) if (((l + 1 < NLAYER) ? PH_MASK0 : PH_MASK) & (1 << 9)) {
        if (rep_ > 0) { PHASE_SYNC(); }
        rmsnorm_rows<true>(a.out, a.in[35] + l * 2048, hbuf, nullptr);
        }
        PHASE_SYNC();
        for (int rep_ = 0; rep_ < (((PH_DUP >> 10) & 1) ? 2 : 1); ++rep_) if (((l + 1 < NLAYER) ? PH_MASK0 : PH_MASK) & (1 << 10)) {
        if (rep_ > 0) { PHASE_SYNC(); }
        { EpiFfn e; e.act = (bf16_t*)(ws + OFF_ACT);
          run_gemm(smem, hbuf, (const bf16_t*)(ws + OFF_WFF), 11264, 2048, e); }
        }
        PHASE_SYNC();
        for (int rep_ = 0; rep_ < (((PH_DUP >> 11) & 1) ? 2 : 1); ++rep_) if (((l + 1 < NLAYER) ? PH_MASK0 : PH_MASK) & (1 << 11)) {
        if (rep_ > 0) { PHASE_SYNC(); }
        { EpiRes e; e.base = a.out; e.out = a.out;
          run_gemm(smem, (const bf16_t*)(ws + OFF_ACT), (const bf16_t*)(ws + OFF_WD), 2048, FFN, e); }
        }
        PHASE_SYNC();
}
__global__ void __launch_bounds__(NTHR) hybrid_encoder_fwd(Args a) {
    unsigned char* smem = g_smem;
    cg::grid_group grid = cg::this_grid();
    unsigned char* ws = launder_ws(a.ws);
    bf16_t* hbuf = (bf16_t*)(ws + OFF_H);
#if defined(WS_FILL)
    { u32x4* p = (u32x4*)(ws + 8192); const size_t n = (WS_END - 8192) / 16; const u32x4 v = {WS_FILL, WS_FILL, WS_FILL, WS_FILL};
      for (size_t i = (size_t)lbid() * NTHR + ltid(); i < n; i += (size_t)gridDim.x * NTHR) p[i] = v; }
    PHASE_SYNC();
#endif
    unsigned* xbar = (unsigned*)(launder_ws(a.ws) + OFF_XBAR);
    volatile XLAS unsigned* xst = (volatile XLAS unsigned*)(g_smem + LDS_BYTES - 64);
    if (ltid() == 0) { xst[0] = 0u; xst[1] = 0u; xst[2] = 0u; xst[3] = 0u; }
    if (lbid() == 0) { for (int i = ltid(); i < XCD_BAR_WORDS; i += NTHR) __hip_atomic_store(xbar + i, 0u, __ATOMIC_RELAXED, __HIP_MEMORY_SCOPE_AGENT); }
    asm volatile("s_waitcnt vmcnt(0) lgkmcnt(0)" ::: "memory"); __builtin_amdgcn_fence(__ATOMIC_RELEASE, "agent"); asm volatile("s_waitcnt vmcnt(0)" ::: "memory"); __syncthreads();
    grid.sync();
    __builtin_amdgcn_fence(__ATOMIC_ACQUIRE, "agent"); asm volatile("s_waitcnt vmcnt(0)" ::: "memory"); __syncthreads();
    const XcdBarrier xb = xcd_barrier_post(xbar, xst);
    run_layer<0>(a, smem, xb);
    if (NLAYER > 1) run_layer<1>(a, smem, xb);
#if defined(DBG_STOP)
    DBG_AT(0, OFF_H, M*2048, OFF_WIN, DINP*2048, OFF_WG, 8192*2048, OFF_WBR, 2048*2560)
    DBG_AT(1, OFF_BUFA, M*1536, OFF_BUFB, M*1536, OFF_BUFD, M*1536, OFF_BUFC, M*2048)
    DBG_AT(2, OFF_BUFA, M*1536, OFF_ALO, 3*M*256, OFF_ZT, 512*8*2048, OFF_VTA, 3*8*256*2048)
    DBG_AT(3, OFF_SLD, 2*M*512, OFF_SA, 2*M*512, OFF_GBUF, M*512, OFF_GBUF, M*512)
    DBG_AT(4, OFF_OA, M*1024, OFF_OD, M*512, OFF_OCDIR, 2*M*512, OFF_YT, 2*512*8*2048)
    DBG_AT(40, OFF_OA, M*1024, OFF_OA, M*1024, OFF_OD, M*512, OFF_OD, M*512)
    DBG_AT(41, OFF_OCDIR, 2*M*512, OFF_OCDIR, 2*M*512, OFF_OCDIR, 2*M*512, OFF_YT, 2*512*8*2048)
    DBG_AT(42, OFF_OA, M*1024, OFF_OA, M*1024, OFF_OA, M*1024, OFF_OA, M*1024)
    DBG_AT(43, OFF_OCDIR, 2*M*512, OFF_OCDIR, 2*M*512, OFF_OCDIR, 2*M*512, OFF_OCDIR, 2*M*512)
    DBG_AT(5, OFF_OB, M*512, OFF_OC, M*512, OFF_OB, M*512, OFF_OC, M*512)
    DBG_AT(6, OFF_P, M*8192, OFF_P, M*8192, OFF_P, M*8192, OFF_P, M*8192)
    DBG_AT(7, OFF_MERGED, M*2048, OFF_MERGED, M*2048, OFF_MERGED, M*2048, OFF_MERGED, M*2048)
    if (DBG_STOP == 11) { for (size_t i = (size_t)lbid() * NTHR + ltid(); i < (size_t)M * D; i += (size_t)gridDim.x * NTHR) { const float v = a.out[i]; a.out[i] = (fabsf(v) < 1e30f) ? v : 1e9f; } }
#else
    rmsnorm_rows<false>(a.out, a.in[39], nullptr, a.out);
#endif
}

extern "C" void kernel_launch(void* const* d_in, const int* in_sizes, int n_in, void* d_out, int out_size, void* d_ws, size_t ws_size, hipStream_t stream) {
    static int grid = 0;
    if (grid == 0) {
        if (n_in != 40 || out_size != M * D || ws_size < WS_END) { fprintf(stderr, "kernel_launch: unexpected shapes (n_in %d out %d ws %zu need %zu)\n", n_in, out_size, ws_size, (size_t)WS_END); grid = -1; return; }
        int dev = 0, cus = 0;
        hipGetDevice(&dev); hipDeviceGetAttribute(&cus, hipDeviceAttributeMultiprocessorCount, dev);
        if (hipFuncSetAttribute((const void*)hybrid_encoder_fwd, hipFuncAttributeMaxDynamicSharedMemorySize, LDS_BYTES) != hipSuccess) { fprintf(stderr, "kernel_launch: hipFuncSetAttribute failed\n"); grid = -1; return; }
        int per_cu = 0;
        hipOccupancyMaxActiveBlocksPerMultiprocessor(&per_cu, (const void*)hybrid_encoder_fwd, NTHR, LDS_BYTES);
        (void)hipGetLastError();
        grid = cus > 0 ? cus : 256;
    }
    if (grid < 0) return;
    Args a{};
    for (int i = 0; i < 40; ++i) a.in[i] = (const float*)d_in[i];
    a.out = (float*)d_out; a.ws = (unsigned char*)d_ws;
    void* args[] = {&a};
    hipError_t e = hipLaunchCooperativeKernel((const void*)hybrid_encoder_fwd, dim3(grid), dim3(NTHR), args, LDS_BYTES, stream);
    if (e != hipSuccess) fprintf(stderr, "cooperative launch failed: %s (grid %d)\n", hipGetErrorString(e), grid);
}
```

```cpp
#ifndef PG8_V2
#define PG8_V2 1
#endif
#ifndef PG8_SP2
#define PG8_SP2 true
#endif
#include <hip/hip_runtime.h>
#include <hip/hip_cooperative_groups.h>
#include <cstdio>
#include <cstdint>
namespace cg = cooperative_groups;
namespace pg8 {
#define PG8_LAS __attribute__((address_space(3)))
typedef unsigned short bf16_t;
typedef short bf16x8 __attribute__((ext_vector_type(8)));
typedef float f32x4 __attribute__((ext_vector_type(4)));
typedef unsigned u32x4 __attribute__((ext_vector_type(4)));
constexpr int BM = 256, BK = 64, HALF = 128, HTB = HALF * BK * 2  , STAGE_BYTES = 8 * HTB, NXCD = 8, WGM = 8;

__host__ __device__ __forceinline__ int lds_byte(int r, int c) { const int st = (r >> 4) * 2 + (c >> 5), rr = r & 15, cc = c & 31, ob = rr * 64 + cc * 2; return st * 1024 + (ob ^ (((ob >> 9) & 1) << 5)); }
__host__ __device__ __forceinline__ void stage_rc(int b, int& R, int& C) { const int st = b / 1024, sb = b % 1024, swz = sb ^ (((sb >> 9) & 1) << 5); R = (st >> 1) * 16 + swz / 64; C = (st & 1) * 32 + (swz % 64) / 2; }
__host__ __device__ __forceinline__ int perm32(int rho) { const int n = rho >> 4, i = rho & 15; return 8 * (i >> 2) + 4 * n + (i & 3); }

struct Unit { int pm, pn; };
struct Gemm { const bf16_t* A; const bf16_t* Bt; int M, N, K; };

struct StaticOrder {
    int nM, nN, nwg, G, c;
    __host__ __device__ void init(int M, int N, int G_, int c_) { nM = M / BM; nN = N / BM; nwg = nM * nN; G = G_; c = c_; }
    __host__ __device__ bool next(int i, Unit& u) const {
        const long L = (long)i * G + c; if (L >= nwg) return false;
        int wgid = (int)L; { const int q = nwg / NXCD, r = nwg % NXCD, xcd = wgid % NXCD, off = wgid / NXCD; wgid = (xcd < r ? xcd * (q + 1) : r * (q + 1) + (xcd - r) * q) + off; }
        const int nig = WGM * nN, gid = wgid / nig, fm = gid * WGM, gsz = (nM - fm) < WGM ? (nM - fm) : WGM;
        u.pm = fm + ((wgid % nig) % gsz); u.pn = (wgid % nig) / gsz; return true;
    }
    __device__ __forceinline__ void a_ready(const Unit&) const {}
    __device__ __forceinline__ void done(const Unit&) const {}
};
__device__ __forceinline__ unsigned cvt_pk_bf16(float lo, float hi) { unsigned r; asm volatile("v_cvt_pk_bf16_f32 %0, %1, %2" : "=v"(r) : "v"(lo), "v"(hi)); return r; }
typedef float f32x2 __attribute__((ext_vector_type(2)));
template <class Epi, class Sched, bool ALIGN_EPI = false, bool SP2 = false>
__device__ __forceinline__ void gemm_phase(PG8_LAS unsigned char* lds, const Gemm g, const Sched& S, const Epi& E) {
    int tid = threadIdx.x; asm volatile("" : "+v"(tid));
    const int wid = __builtin_amdgcn_readfirstlane(tid >> 6), lane = tid & 63, wr = wid >> 2, wc = wid & 3, fr = lane & 15, fq = lane >> 4;
    const int K = g.K, nt = K / BK;
    unsigned voffA[2], voffB[2];
#pragma unroll
    for (int i = 0; i < 2; ++i) { int R, C; stage_rc(tid * 16 + i * 8192, R, C); const int Rb = Epi::PERM ? ((R & ~31) + perm32(R & 31)) : R;
        voffA[i] = (unsigned)(R * K + C) * 2u; voffB[i] = (unsigned)(Rb * K + C) * 2u; }
    const size_t kstep = (size_t)(BK * 2);
    const size_t hstep = (size_t)HALF * K * 2;
    const size_t tstep = 2 * hstep;
    const unsigned ldsw = (unsigned)wid * 1024u;
    const int aoff = lds_byte(wr * 64 + fr, fq * 8), boff = lds_byte(wc * 32 + fr, fq * 8);
#define PG8_SA(b, h) (((b) * 2 + (h)) * HTB)
#define PG8_SB(b, h) ((4 + (b) * 2 + (h)) * HTB)
#define PG8_STAGE(bufoff, gbase, voff) do { _Pragma("unroll") for (int _i = 0; _i < 2; ++_i) \
        __builtin_amdgcn_global_load_lds((const unsigned*)((const char*)(gbase) + (voff)[_i]), (PG8_LAS unsigned*)(lds + (bufoff) + ldsw + _i * 8192), 16, 0, 0); } while (0)
#define PG8_LDA(dst, b, h) do { _Pragma("unroll") for (int m = 0; m < 4; ++m) _Pragma("unroll") for (int k = 0; k < 2; ++k) dst[m][k] = *(const PG8_LAS bf16x8*)(lds + PG8_SA(b, h) + aoff + m * 2048 + k * 1024); } while (0)
#define PG8_LDB(dst, b, h) do { _Pragma("unroll") for (int n = 0; n < 2; ++n) _Pragma("unroll") for (int k = 0; k < 2; ++k) dst[n][k] = *(const PG8_LAS bf16x8*)(lds + PG8_SB(b, h) + boff + n * 2048 + k * 1024); } while (0)
#define PG8_MMA(ai, bj, At, Bt) do { __builtin_amdgcn_s_setprio(1); _Pragma("unroll") for (int m = 0; m < 4; ++m) _Pragma("unroll") for (int n = 0; n < 2; ++n) _Pragma("unroll") for (int k = 0; k < 2; ++k) \
        acc[ai][bj][m][n] = __builtin_amdgcn_mfma_f32_16x16x32_bf16(Bt[n][k], At[m][k], acc[ai][bj][m][n], 0, 0, 0); __builtin_amdgcn_s_setprio(0); } while (0)
#define PG8_WAIT_V(n) asm volatile("s_waitcnt vmcnt(" #n ")" ::: "memory")
#define PG8_WAIT_L(n) asm volatile("s_waitcnt lgkmcnt(" #n ")" ::: "memory")
#define PG8_BAR __builtin_amdgcn_s_barrier()
#define PG8_SCHED __builtin_amdgcn_sched_barrier(0)
    Unit cur, nxt; int ui = 0;
    if (!S.next(0, cur)) return;
    f32x4 acc[2][2][4][2];
#pragma unroll
    for (int a = 0; a < 2; ++a)
#pragma unroll
        for (int b = 0; b < 2; ++b)
#pragma unroll
            for (int m = 0; m < 4; ++m)
#pragma unroll
                for (int n = 0; n < 2; ++n) acc[a][b][m][n] = (f32x4){0.f, 0.f, 0.f, 0.f};
    bf16x8 At[4][2], B0[2][2], B1[2][2];
    const char* cA = (const char*)g.A + (size_t)cur.pm * tstep; const char* cB = (const char*)g.Bt + (size_t)cur.pn * tstep;
    S.a_ready(cur);
    if constexpr (SP2) {
        PG8_STAGE(PG8_SB(0, 0), cB, voffB); PG8_STAGE(PG8_SB(0, 1), cB + hstep, voffB); PG8_STAGE(PG8_SA(0, 0), cA, voffA); PG8_STAGE(PG8_SA(0, 1), cA + hstep, voffA);
        if (wr == 1) PG8_BAR;
        PG8_WAIT_V(2); PG8_BAR;
        PG8_STAGE(PG8_SB(1, 0), cB + kstep, voffB); PG8_STAGE(PG8_SA(1, 0), cA + kstep, voffA); PG8_STAGE(PG8_SB(1, 1), cB + hstep + kstep, voffB);
        PG8_WAIT_V(6); PG8_BAR;
    } else {
        PG8_STAGE(PG8_SB(0, 0), cB, voffB); PG8_STAGE(PG8_SA(0, 0), cA, voffA); PG8_STAGE(PG8_SB(0, 1), cB + hstep, voffB); PG8_STAGE(PG8_SA(0, 1), cA + hstep, voffA);
        if (wr == 1) PG8_BAR;
        PG8_WAIT_V(4); PG8_BAR;
        PG8_STAGE(PG8_SB(1, 0), cB + kstep, voffB); PG8_STAGE(PG8_SA(1, 0), cA + kstep, voffA); PG8_STAGE(PG8_SB(1, 1), cB + hstep + kstep, voffB);
        PG8_WAIT_V(6); PG8_BAR;
    }
    for (;;) {
        const bool has_next = S.next(ui + 1, nxt);
        const char* nA = has_next ? (const char*)g.A + (size_t)nxt.pm * tstep : cA; const char* nB = has_next ? (const char*)g.Bt + (size_t)nxt.pn * tstep : cB;
        for (int t = 0; t < nt; t += 2) {
            const bool last = (t == nt - 2);
            const char* a1 = cA + (size_t)(t + 1) * kstep;
            const char* a2 = last ? nA : cA + (size_t)(t + 2) * kstep; const char* b2 = last ? nB : cB + (size_t)(t + 2) * kstep;
            const char* a3 = a2 + kstep; const char* b3 = b2 + kstep;
            if (last && has_next) S.a_ready(nxt);
            if constexpr (SP2) {
            PG8_LDB(B0, 0, 0); PG8_LDB(B1, 0, 1); PG8_SCHED; PG8_LDA(At, 0, 0); PG8_STAGE(PG8_SA(1, 1), a1 + hstep, voffA);
            PG8_WAIT_V(8); PG8_WAIT_L(0); PG8_BAR; PG8_MMA(0, 0, At, B0); PG8_MMA(0, 1, At, B1); PG8_BAR; PG8_SCHED;
            PG8_LDA(At, 0, 1); PG8_STAGE(PG8_SB(0, 0), b2, voffB); PG8_STAGE(PG8_SB(0, 1), b2 + hstep, voffB); PG8_STAGE(PG8_SA(0, 0), a2, voffA);
            PG8_WAIT_V(8); PG8_WAIT_L(0); PG8_BAR; PG8_MMA(1, 0, At, B0); PG8_MMA(1, 1, At, B1); PG8_BAR; PG8_SCHED;
            PG8_LDB(B0, 1, 0); PG8_LDB(B1, 1, 1); PG8_SCHED; PG8_LDA(At, 1, 0); PG8_STAGE(PG8_SA(0, 1), a2 + hstep, voffA);
            PG8_WAIT_V(8); PG8_WAIT_L(0); PG8_BAR; PG8_MMA(0, 0, At, B0); PG8_MMA(0, 1, At, B1); PG8_BAR; PG8_SCHED;
            PG8_LDA(At, 1, 1); PG8_STAGE(PG8_SB(1, 0), b3, voffB); PG8_STAGE(PG8_SB(1, 1), b3 + hstep, voffB); PG8_STAGE(PG8_SA(1, 0), a3, voffA);
            PG8_WAIT_V(8); PG8_WAIT_L(0); PG8_BAR; PG8_MMA(1, 0, At, B0); PG8_MMA(1, 1, At, B1); PG8_BAR; PG8_SCHED;
            } else {
            PG8_LDB(B0, 0, 0); PG8_SCHED; PG8_LDA(At, 0, 0); PG8_STAGE(PG8_SA(1, 1), a1 + hstep, voffA);
            PG8_WAIT_L(8); PG8_BAR; PG8_WAIT_L(0); PG8_MMA(0, 0, At, B0); PG8_BAR; PG8_SCHED;
            PG8_LDB(B1, 0, 1); PG8_STAGE(PG8_SB(0, 0), b2, voffB);
            PG8_BAR; PG8_WAIT_L(0); PG8_MMA(0, 1, At, B1); PG8_BAR;
            PG8_LDA(At, 0, 1); PG8_STAGE(PG8_SA(0, 0), a2, voffA);
            PG8_BAR; PG8_WAIT_L(0); PG8_MMA(1, 0, At, B0); PG8_BAR; PG8_SCHED;
            PG8_STAGE(PG8_SB(0, 1), b2 + hstep, voffB);
            PG8_WAIT_V(6); PG8_BAR; PG8_MMA(1, 1, At, B1); PG8_BAR;
            PG8_LDB(B0, 1, 0); PG8_SCHED; PG8_LDA(At, 1, 0); PG8_STAGE(PG8_SA(0, 1), a2 + hstep, voffA);
            PG8_WAIT_L(8); PG8_BAR; PG8_WAIT_L(0); PG8_MMA(0, 0, At, B0); PG8_BAR; PG8_SCHED;
            PG8_LDB(B1, 1, 1); PG8_STAGE(PG8_SB(1, 0), b3, voffB);
            PG8_BAR; PG8_WAIT_L(0); PG8_MMA(0, 1, At, B1); PG8_BAR;
            PG8_LDA(At, 1, 1); PG8_STAGE(PG8_SA(1, 0), a3, voffA);
            PG8_BAR; PG8_WAIT_L(0); PG8_MMA(1, 0, At, B0); PG8_BAR; PG8_SCHED;
            PG8_STAGE(PG8_SB(1, 1), b3 + hstep, voffB);
            PG8_WAIT_V(6); PG8_BAR; PG8_MMA(1, 1, At, B1); PG8_BAR;
            }
        }
        if constexpr (ALIGN_EPI) { if (wr == 0) PG8_BAR; }
        if constexpr (!Epi::AFTER_DRAIN) { E(acc, cur, wr, wc, fr, fq); S.done(cur); }
        if (!has_next) break;
#pragma unroll
        for (int a = 0; a < 2; ++a)
#pragma unroll
            for (int b = 0; b < 2; ++b)
#pragma unroll
                for (int m = 0; m < 4; ++m)
#pragma unroll
                    for (int n = 0; n < 2; ++n) acc[a][b][m][n] = (f32x4){0.f, 0.f, 0.f, 0.f};
        cur = nxt; cA = nA; cB = nB; ++ui;
        if constexpr (ALIGN_EPI) { if (wr == 1) PG8_BAR; }
    }
    PG8_WAIT_V(0);
    if constexpr (!ALIGN_EPI) { if (wr == 0) PG8_BAR; }
    PG8_BAR;
    if constexpr (Epi::AFTER_DRAIN) { E.fused(acc, cur, wr, wc, fr, fq, lds, wid, lane); S.done(cur); }
#undef PG8_SA
#undef PG8_SB
#undef PG8_STAGE
#undef PG8_LDA
#undef PG8_LDB
#undef PG8_MMA
#undef PG8_WAIT_V
#undef PG8_WAIT_L
#undef PG8_BAR
#undef PG8_SCHED
}
}
#define XB_TMO      128
#define XB_XCNT(j)  (256  + 64 * (j))
#define XB_XSUB(j)  (1280 + 64 * (j))
#define XB_XGEN(j)  (2304 + 64 * (j))
#define XB_TOP      3328
#define XB_TOPGEN   3392
#define XCD_BAR_WORDS 3456
#define XB_SPIN_CAP (1u << 18)
#define XLAS __attribute__((address_space(3)))

__device__ __forceinline__ unsigned xb_ld(unsigned* p)              { return __hip_atomic_load(p, __ATOMIC_RELAXED, __HIP_MEMORY_SCOPE_AGENT); }
__device__ __forceinline__ unsigned xb_add(unsigned* p, unsigned v) { return __hip_atomic_fetch_add(p, v, __ATOMIC_RELAXED, __HIP_MEMORY_SCOPE_AGENT); }
__device__ __forceinline__ unsigned xb_xcc_id() { return (unsigned)__builtin_amdgcn_s_getreg((3 << 11) | 20) & 0xFu; }
#define XB_SPIN(cond, bar) do { unsigned _sp = 0; while (cond) { __builtin_amdgcn_s_sleep(1); \
    if ((++_sp & 255u) == 0u) { if (xb_ld(&(bar)[XB_TMO])) break; if (_sp > XB_SPIN_CAP) { atomicAdd(&(bar)[XB_TMO], 1u); break; } } } } while (0)

struct XcdBarrier {
    unsigned* bar; unsigned x;
    volatile XLAS unsigned* st;
};

__device__ __forceinline__ XcdBarrier xcd_barrier_post(unsigned* bar, volatile XLAS unsigned* st) {
    XcdBarrier b; b.bar = bar; b.x = xb_xcc_id(); b.st = st;
    if (threadIdx.x == 0) (void)xb_add(&bar[XB_XCNT(b.x)], 1u);
    return b;
}
__device__ __forceinline__ void xcd_barrier_complete(unsigned* bar, unsigned x, unsigned& nloc, unsigned& nx) {
    const unsigned G = gridDim.x * gridDim.y * gridDim.z;
    unsigned sum, cnt, mine, sp = 0u;
    for (;;) {
        sum = 0u; cnt = 0u; mine = 0u;
#pragma unroll
        for (unsigned j = 0; j < 16; ++j) { const unsigned c = xb_ld(&bar[XB_XCNT(j)]); sum += c; cnt += (c > 0u) ? 1u : 0u; mine = (j == x) ? c : mine; }
        if (sum == G) break;
        __builtin_amdgcn_s_sleep(1);
        if ((++sp & 255u) == 0u) { if (xb_ld(&bar[XB_TMO])) break; if (sp > XB_SPIN_CAP) { atomicAdd(&bar[XB_TMO], 1u); break; } }
    }
    nloc = mine > 0u ? mine : 1u; nx = cnt > 0u ? cnt : 1u;
}

__device__ __forceinline__ void xcd_barrier(const XcdBarrier& b) {
    asm volatile("s_waitcnt vmcnt(0)" ::: "memory");
    __syncthreads();
    if (threadIdx.x == 0) {
        unsigned* bar = b.bar;
        __builtin_amdgcn_s_waitcnt(0);
        unsigned nloc = b.st[0], nx = b.st[1];
        if (nloc == 0u) { xcd_barrier_complete(bar, b.x, nloc, nx); b.st[0] = nloc; b.st[1] = nx; }
        const unsigned old = xb_add(&bar[XB_XSUB(b.x)], 1u);
        const unsigned gen = old / nloc;
        if (old + 1u == (gen + 1u) * nloc) {
            __builtin_amdgcn_fence(__ATOMIC_RELEASE, "agent");
            asm volatile("s_waitcnt vmcnt(0)" ::: "memory");
            const unsigned og = xb_add(&bar[XB_TOP], 1u);
            const unsigned tg = og / nx;
            if (og + 1u == (tg + 1u) * nx) xb_add(&bar[XB_TOPGEN], 1u);
            else XB_SPIN(xb_ld(&bar[XB_TOPGEN]) == tg, bar);
            __builtin_amdgcn_fence(__ATOMIC_ACQUIRE, "agent");
            xb_add(&bar[XB_XGEN(b.x)], 1u);
            asm volatile("s_waitcnt vmcnt(0)" ::: "memory");
        } else {
            XB_SPIN(xb_ld(&bar[XB_XGEN(b.x)]) == gen, bar);
            __builtin_amdgcn_fence(__ATOMIC_ACQUIRE, "agent");
            asm volatile("s_waitcnt vmcnt(0)" ::: "memory");
        }
    }
    __syncthreads();
}

using pg8::bf16_t; using pg8::bf16x8; using pg8::f32x4; using pg8::u32x4;
typedef float f32x16 __attribute__((ext_vector_type(16)));
typedef unsigned u32x2 __attribute__((ext_vector_type(2)));
#define LAS __attribute__((address_space(3)))

constexpr int D = 2048, NBATCH = 8, T = 2048, M = NBATCH * T, FFN = 5632, DINP = 6656;
constexpr int NTHR = 512;
constexpr int LDS_BYTES = 143360;

constexpr size_t al256(size_t x) { return (x + 255) & ~(size_t)255; }
constexpr size_t OFF_CTL = 0;
constexpr size_t OFF_LAM = 4096;
constexpr size_t OFF_HID3 = 8192;
constexpr size_t OFF_WIN = OFF_HID3 + (size_t)2 * 2048 * 64 * 4;
constexpr size_t OFF_WG = OFF_WIN + (size_t)DINP * 2048 * 2;
constexpr size_t OFF_WBR = OFF_WG + (size_t)8192 * 2048 * 2;
constexpr size_t OFF_WO = OFF_WBR + (size_t)2048 * 2560 * 2;
constexpr size_t OFF_WLORA = OFF_WO + (size_t)2048 * 2048 * 2;
constexpr size_t OFF_WGUP = OFF_WLORA + (size_t)2 * 1024 * 256 * 2;
constexpr size_t OFF_H = OFF_WGUP + (size_t)512 * 256 * 2;
constexpr size_t OFF_OA = OFF_H + (size_t)M * 2048 * 2;
constexpr size_t OFF_OB = OFF_OA + (size_t)M * 1024 * 2;
constexpr size_t OFF_OC = OFF_OB + (size_t)M * 512 * 2;
constexpr size_t OFF_OD = OFF_OC + (size_t)M * 512 * 2;
constexpr size_t OFF_MERGED = OFF_OA;
constexpr size_t OFF_BIG = OFF_OD + (size_t)M * 512 * 2;
constexpr size_t OFF_BUFA = OFF_BIG;
constexpr size_t OFF_BUFB = OFF_BUFA + (size_t)M * 1536 * 2;
constexpr size_t OFF_BUFD = OFF_BUFB + (size_t)M * 1536 * 2;
constexpr size_t OFF_BUFC = OFF_BUFD + (size_t)M * 1536 * 2;
constexpr size_t OFF_SLD = OFF_BUFC + (size_t)M * 2048 * 2;
constexpr size_t OFF_SA = OFF_SLD + (size_t)2 * M * 512 * 2;
constexpr size_t OFF_ZT = OFF_SA + (size_t)2 * M * 512 * 2;
constexpr size_t OFF_VTA = OFF_ZT + (size_t)512 * 8 * 2048 * 2;
constexpr size_t OFF_VTD = OFF_VTA + (size_t)8 * 256 * 2048 * 2;
constexpr size_t OFF_GBUF = OFF_VTD + (size_t)8 * 512 * 2048 * 2;
constexpr size_t OFF_OCDIR = OFF_GBUF + (size_t)M * 512 * 2;
constexpr size_t OFF_YT = OFF_OCDIR + (size_t)2 * M * 512 * 2;
constexpr size_t OFF_ALO = OFF_YT;
constexpr size_t OFF_AG = OFF_ALO + (size_t)2 * M * 256 * 2;
constexpr size_t OFF_BIGEND = OFF_YT + (size_t)512 * 8 * 2048 * 4;
constexpr size_t OFF_P = OFF_BIG;
constexpr size_t OFF_ACT = OFF_BIG;
constexpr size_t OFF_XBAR = OFF_BIGEND;
constexpr size_t OFF_WFF = OFF_BIGEND + 16384;
constexpr size_t OFF_WD = OFF_WFF + (size_t)11264 * 2048 * 2;
constexpr size_t WS_END = OFF_WD + (size_t)2048 * FFN * 2;
static_assert(OFF_P + (size_t)M * 8192 * 2 <= OFF_BIGEND, "P alias");
static_assert(OFF_AG + (size_t)M * 256 * 2 <= OFF_BIGEND, "Ag alias");
static_assert(WS_END <= 732154368ull, "workspace");

struct Args { const float* in[40]; float* out; unsigned char* ws; };
extern __shared__ __attribute__((aligned(16))) unsigned char g_smem[];

typedef __attribute__((address_space(1))) unsigned char gas_uchar;
__device__ __forceinline__ unsigned char* launder_ws(unsigned char* p) { gas_uchar* g = (gas_uchar*)p; asm volatile("" : "+s"(g)); return (unsigned char*)g; }
__device__ __forceinline__ float bf2f(bf16_t v) { return __uint_as_float(((unsigned)v) << 16); }
__device__ __forceinline__ float bflo(unsigned v) { return __uint_as_float(v << 16); }
__device__ __forceinline__ float bfhi(unsigned v) { return __uint_as_float(v & 0xffff0000u); }
typedef float f32x2c_ __attribute__((ext_vector_type(2)));
typedef __bf16 bf16x2c_ __attribute__((ext_vector_type(2)));
__device__ __forceinline__ unsigned pk2(float lo, float hi) { const f32x2c_ v = {lo, hi}; const bf16x2c_ b = __builtin_convertvector(v, bf16x2c_); return __builtin_bit_cast(unsigned, b); }
__device__ __forceinline__ bf16_t f2bf(float f) { return (bf16_t)(pk2(f, 0.f) & 0xffffu); }
__device__ __forceinline__ int ltid() { int t = threadIdx.x; asm volatile("" : "+v"(t)); return t; }
__device__ __forceinline__ int lbid() { int b = blockIdx.x; asm volatile("" : "+s"(b)); return b; }
__device__ __forceinline__ float shx(float v, int mask, int lane) { return __int_as_float(__builtin_amdgcn_ds_bpermute((lane ^ mask) << 2, __float_as_int(v))); }
template <int CTRL> __device__ __forceinline__ float dppf(float v) { return __int_as_float(__builtin_amdgcn_update_dpp(0, __float_as_int(v), CTRL, 0xF, 0xF, true)); }
__device__ __forceinline__ float wave_sum(float v, int lane) {
    v += dppf<0xB1>(v); v += dppf<0x4E>(v); v += dppf<0x141>(v); v += dppf<0x140>(v);
    v += shx(v, 16, lane);
    return v + shx(v, 32, lane);
}
__device__ __forceinline__ float half_sum(float v, int lane) {
    v += dppf<0xB1>(v); v += dppf<0x4E>(v); v += dppf<0x141>(v); v += dppf<0x140>(v);
    return v + shx(v, 16, lane);
}
__device__ __forceinline__ float sum8(float v) {
    v += dppf<0xB1>(v); v += dppf<0x4E>(v); v += dppf<0x141>(v); return v;
}
__device__ __forceinline__ float sigmoidf_(float x) { return __builtin_amdgcn_rcpf(1.f + __expf(-x)); }

struct EpiIn {
    static constexpr bool PERM = true, AFTER_DRAIN = false;
    bf16_t *bA, *bB, *bD, *bC;
    __device__ __forceinline__ void operator()(const f32x4 (&acc)[2][2][4][2], const pg8::Unit& u, int wr, int wc, int fr, int fq) const {
        bf16_t* base; int ldc, ct;
        if (u.pn < 6) { base = bA; ldc = 1536; ct = u.pn; } else if (u.pn < 12) { base = bB; ldc = 1536; ct = u.pn - 6; }
        else if (u.pn < 18) { base = bD; ldc = 1536; ct = u.pn - 12; } else { base = bC; ldc = 2048; ct = u.pn - 18; }
        const int row0 = u.pm * 256 + wr * 64 + fr, col0 = ct * 256 + wc * 32 + 8 * fq;
#pragma unroll
        for (int ai = 0; ai < 2; ++ai)
#pragma unroll
            for (int m = 0; m < 4; ++m) { bf16_t* rowp = base + (size_t)(row0 + ai * 128 + m * 16) * ldc + col0;
#pragma unroll
                for (int bj = 0; bj < 2; ++bj) { const f32x4 v0 = acc[ai][bj][m][0], v1 = acc[ai][bj][m][1];
                    u32x4 w; w.x = pk2(v0[0], v0[1]); w.y = pk2(v0[2], v0[3]); w.z = pk2(v1[0], v1[1]); w.w = pk2(v1[2], v1[3]);
                    *(u32x4*)(rowp + bj * 128) = w; } }
    }
};
struct EpiBf {
    static constexpr bool PERM = true, AFTER_DRAIN = false;
    bf16_t* O; int ldc; int coff;
    __device__ __forceinline__ void operator()(const f32x4 (&acc)[2][2][4][2], const pg8::Unit& u, int wr, int wc, int fr, int fq) const {
        const int row0 = u.pm * 256 + wr * 64 + fr, col0 = coff + u.pn * 256 + wc * 32 + 8 * fq;
#pragma unroll
        for (int ai = 0; ai < 2; ++ai)
#pragma unroll
            for (int m = 0; m < 4; ++m) { bf16_t* rowp = O + (size_t)(row0 + ai * 128 + m * 16) * ldc + col0;
#pragma unroll
                for (int bj = 0; bj < 2; ++bj) { const f32x4 v0 = acc[ai][bj][m][0], v1 = acc[ai][bj][m][1];
                    u32x4 w; w.x = pk2(v0[0], v0[1]); w.y = pk2(v0[2], v0[3]); w.z = pk2(v1[0], v1[1]); w.w = pk2(v1[2], v1[3]);
                    *(u32x4*)(rowp + bj * 128) = w; } }
    }
};
struct EpiGate {
    static constexpr bool PERM = false, AFTER_DRAIN = false;
    const bf16_t* P; bf16_t* Mg;
    __device__ __forceinline__ void operator()(const f32x4 (&acc)[2][2][4][2], const pg8::Unit& u, int wr, int wc, int fr, int fq) const {
        const int row0 = u.pm * 256 + wr * 64 + fr, col0 = u.pn * 64 + wc * 16 + 4 * fq;
#pragma unroll
        for (int ai = 0; ai < 2; ++ai)
#pragma unroll
            for (int m = 0; m < 4; ++m) { const size_t row = (size_t)(row0 + ai * 128 + m * 16);
                f32x4 o = {0.f, 0.f, 0.f, 0.f};
#pragma unroll
                for (int g = 0; g < 4; ++g) { const u32x2 pv = *(const u32x2*)(P + row * 8192 + g * 2048 + col0); const f32x4 gv = acc[ai][g >> 1][m][g & 1];
                    o[0] += sigmoidf_(gv[0]) * bflo(pv.x); o[1] += sigmoidf_(gv[1]) * bfhi(pv.x); o[2] += sigmoidf_(gv[2]) * bflo(pv.y); o[3] += sigmoidf_(gv[3]) * bfhi(pv.y); }
                u32x2 w; w.x = pk2(o[0], o[1]); w.y = pk2(o[2], o[3]);
                *(u32x2*)(Mg + row * 2048 + col0) = w; }
    }
};
struct EpiRes {
    static constexpr bool PERM = false, AFTER_DRAIN = false;
    const float* base; float* out;
    __device__ __forceinline__ void operator()(const f32x4 (&acc)[2][2][4][2], const pg8::Unit& u, int wr, int wc, int fr, int fq) const {
        const int row0 = u.pm * 256 + wr * 64 + fr, col0 = u.pn * 256 + wc * 32 + 4 * fq;
#pragma unroll
        for (int ai = 0; ai < 2; ++ai)
#pragma unroll
            for (int m = 0; m < 4; ++m) { const size_t off = (size_t)(row0 + ai * 128 + m * 16) * 2048 + col0;
#pragma unroll
                for (int bj = 0; bj < 2; ++bj)
#pragma unroll
                    for (int n = 0; n < 2; ++n) { const f32x4 bs = *(const f32x4*)(base + off + bj * 128 + n * 16); *(f32x4*)(out + off + bj * 128 + n * 16) = bs + acc[ai][bj][m][n]; } }
    }
};
struct EpiFfn {
    static constexpr bool PERM = true, AFTER_DRAIN = false;
    bf16_t* act;
    __device__ __forceinline__ void operator()(const f32x4 (&acc)[2][2][4][2], const pg8::Unit& u, int wr, int wc, int fr, int fq) const {
        const int row0 = u.pm * 256 + wr * 64 + fr, col0 = u.pn * 128 + wc * 32 + 8 * fq;
#pragma unroll
        for (int ai = 0; ai < 2; ++ai)
#pragma unroll
            for (int m = 0; m < 4; ++m) { bf16_t* rowp = act + (size_t)(row0 + ai * 128 + m * 16) * FFN + col0;
                const f32x4 g0 = acc[ai][0][m][0], g1 = acc[ai][0][m][1], u0 = acc[ai][1][m][0], u1 = acc[ai][1][m][1]; f32x4 o0, o1;
#pragma unroll
                for (int j = 0; j < 4; ++j) { o0[j] = g0[j] * sigmoidf_(g0[j]) * u0[j]; o1[j] = g1[j] * sigmoidf_(g1[j]) * u1[j]; }
                u32x4 w; w.x = pk2(o0[0], o0[1]); w.y = pk2(o0[2], o0[3]); w.z = pk2(o1[0], o1[1]); w.w = pk2(o1[2], o1[3]);
                *(u32x4*)rowp = w; }
    }
};
template <class Epi> __device__ __forceinline__ void run_gemm(unsigned char* smem, const bf16_t* A, const bf16_t* Bt, int N, int K, const Epi& E) {
    pg8::Gemm g; g.A = A; g.Bt = Bt; g.M = M; g.N = N; g.K = K;
    pg8::StaticOrder S; S.init(M, N, (int)gridDim.x, lbid());
    __syncthreads();
#if PG8_V2
#ifndef PG8_ALIGN
#define PG8_ALIGN true
#endif
    pg8::gemm_phase<Epi, pg8::StaticOrder, PG8_ALIGN, PG8_SP2>((PG8_LAS unsigned char*)g_smem, g, S, E);
#else
    pg8::gemm_phase<Epi, pg8::StaticOrder, false>((PG8_LAS unsigned char*)g_smem, g, S, E, nullptr);
#endif
    __syncthreads();
}
__device__ __forceinline__ const float* wsrc(const Args& a, int mat, int l, int np, bool& valid, size_t& ld) {
    valid = true;
    if (mat == 0) { const int sc = np < 3072 ? np : (np < 4608 ? np + 1984 : (np < 6592 ? np - 1536 : -1)); valid = sc >= 0; ld = 6592; return a.in[2] + (size_t)l * 2048 * 6592 + (sc >= 0 ? sc : 0); }
    if (mat == 1) { const int pn = np >> 8, c = np & 255, g = 2 * (c >> 7) + ((c >> 4) & 1), col = 64 * pn + 16 * ((c >> 5) & 3) + (c & 15); ld = 2048; return a.in[32] + ((size_t)(l * 4 + g) * 2048) * 2048 + col; }
    if (mat <= 5) { const int g = mat - 2, koff = g == 0 ? 0 : 1024 + (g - 1) * 512; ld = 2048; return a.in[33] + (size_t)l * 2560 * 2048 + (size_t)koff * 2048 + np; }
    if (mat == 6) { ld = 2048; return a.in[34] + (size_t)l * 2048 * 2048 + np; }
    if (mat == 7) { const int pn = np >> 8, c = np & 255, ty = c >> 7, col = 128 * pn + (c & 127); ld = FFN; return (ty ? a.in[37] : a.in[36]) + (size_t)l * 2048 * FFN + col; }
    ld = 2048; return a.in[38] + (size_t)l * FFN * 2048 + np;
}
struct WItem { int mat, kt, ng, K; bf16_t* dst; };
__device__ __forceinline__ void witem_load(const Args& a, int l, const WItem& w, float (&rg)[32]) {
    const int tid = ltid(), kr = tid >> 6, n4 = tid & 63, k0 = w.kt * 64;
    bool vd; size_t ld = 0; const float* sp = wsrc(a, w.mat, l, w.ng * 256 + 4 * n4, vd, ld);
#pragma unroll
    for (int i = 0; i < 8; ++i) { f32x4 v = {0.f, 0.f, 0.f, 0.f}; if (vd) v = __builtin_nontemporal_load((const f32x4*)(sp + (size_t)(k0 + kr + 8 * i) * ld));
        rg[4 * i] = v[0]; rg[4 * i + 1] = v[1]; rg[4 * i + 2] = v[2]; rg[4 * i + 3] = v[3]; }
}
__device__ __forceinline__ void witem_tolds(float* tile, const float (&rg)[32]) {
    const int tid = ltid(), kr = tid >> 6, n4 = tid & 63, q = n4 >> 4, nc = (n4 & 15) * 4;
#pragma unroll
    for (int i = 0; i < 8; ++i)
#pragma unroll
        for (int e = 0; e < 4; ++e) tile[q * 4160 + (kr + 8 * i) * 65 + nc + e] = rg[4 * i + e];
}
__device__ __forceinline__ void witem_store(const WItem& w, const float* tile) {
    const int tid = ltid(), nr = tid >> 3, kc = tid & 7, k0 = w.kt * 64;
#pragma unroll
    for (int q = 0; q < 4; ++q) { const float* tp = tile + q * 4160 + (kc * 8) * 65 + nr;
        u32x4 o; o.x = pk2(tp[0], tp[65]); o.y = pk2(tp[130], tp[195]); o.z = pk2(tp[260], tp[325]); o.w = pk2(tp[390], tp[455]);
        *(u32x4*)(w.dst + (size_t)((w.ng * 4 + q) * 64 + nr) * w.K + k0 + kc * 8) = o; }
}
__device__ __forceinline__ WItem witem_phase0(unsigned char* wsl, int it) {
    constexpr int I0 = 26 * 32, I1 = 32 * 32, I2 = 8 * 16, I3 = 8 * 8;
    WItem w; int r = it;
    if (r < I0) { w.mat = 0; w.kt = r / 26; w.ng = r % 26; w.K = 2048; w.dst = (bf16_t*)(wsl + OFF_WIN); return w; }
    r -= I0;
    if (r < I1) { w.mat = 1; w.kt = r / 32; w.ng = r % 32; w.K = 2048; w.dst = (bf16_t*)(wsl + OFF_WG); return w; }
    r -= I1;
    if (r < I2) { w.mat = 2; w.kt = r / 8; w.ng = r % 8; w.K = 1024; w.dst = (bf16_t*)(wsl + OFF_WBR); return w; }
    r -= I2;
    if (r < 3 * I3) { const int g = 1 + r / I3; r = r % I3; w.mat = 2 + g; w.kt = r / 8; w.ng = r % 8; w.K = 512; w.dst = (bf16_t*)(wsl + OFF_WBR) + (size_t)2048 * 1024 + (size_t)(g - 1) * 2048 * 512; return w; }
    r -= 3 * I3;
    w.mat = 6; w.kt = r / 8; w.ng = r % 8; w.K = 2048; w.dst = (bf16_t*)(wsl + OFF_WO); return w;
}
__device__ __forceinline__ WItem witem_phase8(unsigned char* wsl, int it) {
    constexpr int I0 = 44 * 32;
    WItem w; int r = it;
    if (r < I0) { w.mat = 7; w.kt = r / 44; w.ng = r % 44; w.K = 2048; w.dst = (bf16_t*)(wsl + OFF_WFF); return w; }
    r -= I0;
    w.mat = 8; w.kt = r / 8; w.ng = r % 8; w.K = FFN; w.dst = (bf16_t*)(wsl + OFF_WD); return w;
}
template <int PH> __device__ __forceinline__ void wconv_run(const Args& a, unsigned char* smem, unsigned char* wsl, int l, int nit, int first = 0) {
    float* tile = (float*)smem;
    const int bid_ = lbid() + first, G = gridDim.x;
    if (bid_ >= nit) return;
    float rg[32];
    WItem cur = PH == 0 ? witem_phase0(wsl, bid_) : witem_phase8(wsl, bid_);
    witem_load(a, l, cur, rg);
    for (int it = bid_; it < nit; it += G) {
        witem_tolds(tile, rg);
        __syncthreads();
        const bool more = it + G < nit;
        WItem nxt = cur;
        if (more) { nxt = PH == 0 ? witem_phase0(wsl, it + G) : witem_phase8(wsl, it + G); witem_load(a, l, nxt, rg); }
        witem_store(cur, tile);
        __syncthreads();
        cur = nxt;
    }
}
__device__ __forceinline__ void wconv_phase0(const Args& a, unsigned char* smem, int l) {
    unsigned char* wsl = launder_ws(a.ws); const int bid_ = lbid();
    constexpr int NIT = 26 * 32 + 32 * 32 + 8 * 16 + 3 * 8 * 8 + 8 * 32;
    wconv_run<0>(a, smem, wsl, l, 26 * 32);
    bf16_t* wl = (bf16_t*)(wsl + OFF_WLORA); bf16_t* wg = (bf16_t*)(wsl + OFF_WGUP);
    const int gt = bid_ * NTHR + ltid(), GT = gridDim.x * NTHR;
    for (int i = gt; i < 2 * 1024 * 256; i += GT) { const int d = i >> 18, np = (i >> 8) & 1023, k = i & 255; float v = 0.f;
        if (np < 512) { if (k < 96) v = a.in[18][((size_t)(l * 2 + d) * 96 + k) * 512 + np]; }
        else { if (k >= 96 && k < 192) v = a.in[20][((size_t)(l * 2 + d) * 96 + (k - 96)) * 512 + (np - 512)]; }
        wl[i] = f2bf(v); }
    for (int i = gt; i < 512 * 256; i += GT) { const int np = i >> 8, k = i & 255; wg[i] = f2bf(a.in[21][((size_t)l * 256 + k) * 512 + np]); }
}
__device__ __forceinline__ void wconv_phase8(const Args& a, unsigned char* smem, int l) {
    unsigned char* wsl = launder_ws(a.ws);
    wconv_run<8>(a, smem, wsl, l, 44 * 32 + 8 * 88);
}
template <bool TOBF, bool COPY = false> __device__ __forceinline__ void rmsnorm_rows(const float* x, const float* g, bf16_t* hout, float* fout, float* xcopy = nullptr) {
    const int tid_ = ltid(), lane = tid_ & 63, wave = tid_ >> 6, bid_ = lbid();
    f32x4 gv[8];
#pragma unroll
    for (int j = 0; j < 8; ++j) gv[j] = ((const f32x4*)g)[lane + 64 * j];
    for (int row = bid_ * 8 + wave; row < M; row += gridDim.x * 8) {
        const f32x4* xr = (const f32x4*)(x + (size_t)row * 2048) + lane;
        f32x4 v[8];
#pragma unroll
        for (int j = 0; j < 8; ++j) v[j] = xr[64 * j];
        asm volatile("" : "+v"(v[0]), "+v"(v[1]), "+v"(v[2]), "+v"(v[3]), "+v"(v[4]), "+v"(v[5]), "+v"(v[6]), "+v"(v[7]));
        float ss = 0.f;
#pragma unroll
        for (int j = 0; j < 8; ++j) ss += (v[j][0] * v[j][0] + v[j][1] * v[j][1]) + (v[j][2] * v[j][2] + v[j][3] * v[j][3]);
        if (COPY) {
#pragma unroll
            for (int j = 0; j < 8; ++j) ((f32x4*)(xcopy + (size_t)row * 2048))[lane + 64 * j] = v[j]; }
        ss = wave_sum(ss, lane);
        const float r = rsqrtf(ss * (1.f / 2048.f) + 1e-6f);
#pragma unroll
        for (int j = 0; j < 8; ++j) { const f32x4 o = v[j] * r * gv[j];
            if (TOBF) { u32x2 w; w.x = pk2(o[0], o[1]); w.y = pk2(o[2], o[3]); ((u32x2*)(hout + (size_t)row * 2048))[lane + 64 * j] = w; }
            else ((f32x4*)(fout + (size_t)row * 2048))[lane + 64 * j] = o; }
    }
}
__device__ __forceinline__ void hid3_and_lam(const Args& a) {
    unsigned char* wsl = launder_ws(a.ws); const int bid_ = lbid();
    const int tid_ = ltid(), lane = tid_ & 63, wave = tid_ >> 6;
    float* hid3 = (float*)(wsl + OFF_HID3);
    for (int it = bid_ * 8 + wave; it < 2 * 2048; it += gridDim.x * 8) {
        const int l = it >> 11, j = it & 2047;
        const float* w1 = a.in[7] + l * 33 * 64; const float* b1 = a.in[8] + l * 64; const float* w2 = a.in[9] + l * 4096; const float* b2 = a.in[10] + l * 64;
        const float* w3 = a.in[11] + l * 4096; const float* b3 = a.in[12] + l * 64; const float fr = a.in[14][l * 64 + lane];
        float ze = 0.f;
        if (lane == 0) ze = (float)j / 2047.f;
        else if (lane < 33) { const int bnd = (lane - 1) & 15; const float band = 1e-4f + (float)bnd * ((15.f - 1e-4f) / 15.f);
            const float ang = ((6.283185307179586f / 2048.f) * (float)j) * band; ze = lane < 17 ? cosf(ang) : -sinf(ang); }
        float acc = b1[lane];
        for (int e = 0; e < 33; ++e) acc += __int_as_float(__builtin_amdgcn_ds_bpermute(e << 2, __float_as_int(ze))) * w1[e * 64 + lane];
        const float h1 = sinf(fr * acc);
        acc = b2[lane];
        for (int e = 0; e < 64; ++e) acc += __int_as_float(__builtin_amdgcn_ds_bpermute(e << 2, __float_as_int(h1))) * w2[e * 64 + lane];
        const float h2 = sinf(fr * acc);
        acc = b3[lane];
        for (int e = 0; e < 64; ++e) acc += __int_as_float(__builtin_amdgcn_ds_bpermute(e << 2, __float_as_int(h2))) * w3[e * 64 + lane];
        hid3[(size_t)it * 64 + lane] = sinf(fr * acc);
    }
    if (bid_ == 0 && wave < 2) { const int l = wave;
        const float s1 = wave_sum(a.in[27][l * 64 + lane] * a.in[28][l * 64 + lane], lane), s2 = wave_sum(a.in[29][l * 64 + lane] * a.in[30][l * 64 + lane], lane);
        const float lam_init = 0.8f - 0.6f * expf(-0.3f * (float)l);
        if (lane == 0) ((float*)(wsl + OFF_LAM))[l] = expf(s1) - expf(s2) + lam_init; }
}
__device__ __forceinline__ float conv3(const bf16_t* bufB, size_t tok, int t, int col, const float* cw, const float* cb) {
    const float u0 = t > 0 ? bf2f(bufB[(tok - 1) * 1536 + col]) : 0.f, u1 = bf2f(bufB[tok * 1536 + col]), u2 = t < T - 1 ? bf2f(bufB[(tok + 1) * 1536 + col]) : 0.f;
    return cw[col] * u0 + cw[1536 + col] * u1 + cw[3072 + col] * u2 + cb[col];
}
__device__ __forceinline__ void tr_store(const bf16_t* tile, bf16_t* dst, size_t rowbase, size_t cmul, int t0) {
    const int tid_ = ltid(), cl = tid_ >> 3, tch = tid_ & 7;
    const u32x4 v = *(const u32x4*)(tile + cl * 72 + tch * 8);
    *(u32x4*)(dst + (rowbase + (size_t)cl * cmul) * T + t0 + tch * 8) = v;
}
__device__ __forceinline__ void prep_phase(const Args& a, unsigned char* smem, int l) {
    unsigned char* wsl = launder_ws(a.ws); const int bid_ = lbid();
    const int tid = ltid(), lane = tid & 63, wave = tid >> 6;
    bf16_t* bufA = (bf16_t*)(wsl + OFF_BUFA); const bf16_t* bufB = (const bf16_t*)(wsl + OFF_BUFB); const bf16_t* bufC = (const bf16_t*)(wsl + OFF_BUFC); const bf16_t* bufD = (const bf16_t*)(wsl + OFF_BUFD);
    {
        const int aa = lane >> 5, i = lane & 31;
        const float invf = exp2f(-(float)(2 * i) * (13.287712379549449f / 64.f));
        const float* qn = a.in[3] + l * 128; const float* kn = a.in[4] + l * 128;
        const float gq0 = qn[aa * 64 + i], gq1 = qn[aa * 64 + 32 + i], gk0 = kn[aa * 64 + i], gk1 = kn[aa * 64 + 32 + i];
        bf16_t* alo = (bf16_t*)(wsl + OFF_ALO); bf16_t* ag = (bf16_t*)(wsl + OFF_AG);
        const float* mu0 = a.in[16] + (size_t)(l * 2 + 0) * 1728; const float* mu1 = a.in[16] + (size_t)(l * 2 + 1) * 1728;
        for (int tok = bid_ * 8 + wave; tok < M; tok += gridDim.x * 8) {
            const int t = tok & (T - 1);
            const float pos = aa == 0 ? (float)(t >> 6) : (float)(t & 63);
            const float ang = pos * invf, cs = cosf(ang), sn = sinf(ang);
            bf16_t* row = bufA + (size_t)tok * 1536;
            float xa[10], xb[10];
#pragma unroll
            for (int hd = 0; hd < 10; ++hd) { const bf16_t* p = row + hd * 128 + aa * 64 + i; xa[hd] = bf2f(p[0]); xb[hd] = bf2f(p[32]); }
#pragma unroll
            for (int hd = 0; hd < 10; ++hd) {
                bf16_t* p = row + hd * 128 + aa * 64 + i;
                const float x0 = xa[hd], x1 = xb[hd];
                const float ss = wave_sum(x0 * x0 + x1 * x1, lane);
                const float r = rsqrtf(ss * (1.f / 128.f) + 1e-6f);
                const float y0 = x0 * r * (hd < 8 ? gq0 : gk0), y1 = x1 * r * (hd < 8 ? gq1 : gk1);
                p[0] = f2bf(y0 * cs - y1 * sn); p[32] = f2bf(y1 * cs + y0 * sn);
            }
            const bf16_t* crow = bufC + (size_t)tok * 2048;
            u32x2 o0 = {0u, 0u}, o1 = {0u, 0u};
            if (lane < 48) {
                const int col = 1536 + lane * 4;
                const u32x2 xc = *(const u32x2*)(crow + col);
                u32x2 xp = {0u, 0u}, xn = {0u, 0u};
                if (t > 0) xp = *(const u32x2*)(crow - 2048 + col);
                if (t < T - 1) xn = *(const u32x2*)(crow + 2048 + col);
                const float c4[4] = {bflo(xc.x), bfhi(xc.x), bflo(xc.y), bfhi(xc.y)};
                const float p4[4] = {bflo(xp.x), bfhi(xp.x), bflo(xp.y), bfhi(xp.y)};
                const float n4[4] = {bflo(xn.x), bfhi(xn.x), bflo(xn.y), bfhi(xn.y)};
                float f0[4], f1[4];
#pragma unroll
                for (int j = 0; j < 4; ++j) { f0[j] = c4[j] + (p4[j] - c4[j]) * mu0[col + j]; f1[j] = c4[j] + (n4[j] - c4[j]) * mu1[col + j];
                    if (lane < 24) { f0[j] = tanhf(f0[j]); f1[j] = tanhf(f1[j]); } }
                o0.x = pk2(f0[0], f0[1]); o0.y = pk2(f0[2], f0[3]); o1.x = pk2(f1[0], f1[1]); o1.y = pk2(f1[2], f1[3]);
            }
            *(u32x2*)(alo + (size_t)tok * 256 + lane * 4) = o0;
            *(u32x2*)(alo + (size_t)(M + tok) * 256 + lane * 4) = o1;
            { const u32x2 xg = *(const u32x2*)(crow + 1728 + lane * 4); u32x2 og;
              og.x = pk2(sigmoidf_(bflo(xg.x)), sigmoidf_(bfhi(xg.x))); og.y = pk2(sigmoidf_(bflo(xg.y)), sigmoidf_(bfhi(xg.y)));
              *(u32x2*)(ag + (size_t)tok * 256 + lane * 4) = og; }
        }
    }
    __syncthreads();
    {
        bf16_t* tile = (bf16_t*)smem;
        bf16_t* zT = (bf16_t*)(wsl + OFF_ZT); bf16_t* vta = (bf16_t*)(wsl + OFF_VTA); bf16_t* vtd = (bf16_t*)(wsl + OFF_VTD);
        const float* cw = a.in[5] + (size_t)l * 3 * 1536; const float* cb = a.in[6] + (size_t)l * 1536;
        const int tl = tid >> 3, c0l = (tid & 7) * 8;
        constexpr int NZ = 8 * 32 * 8, NA = 8 * 32 * 4, ND = 8 * 32 * 8;
        for (int it = bid_; it < NZ + NA + ND; it += gridDim.x) {
            int r = it;
            if (r < NZ) { const int cb_ = r & 7, tb = (r >> 3) & 31, b = r >> 8; const int t = tb * 64 + tl; const size_t tok = (size_t)b * T + t;
                float cv[2][8];
#pragma unroll
                for (int grp = 0; grp < 2; ++grp) { const int col = grp * 512 + cb_ * 64 + c0l;
                    const u32x4 u1 = *(const u32x4*)(bufB + tok * 1536 + col);
                    u32x4 u0 = {0u, 0u, 0u, 0u}, u2 = {0u, 0u, 0u, 0u};
                    if (t > 0) u0 = *(const u32x4*)(bufB + (tok - 1) * 1536 + col);
                    if (t < T - 1) u2 = *(const u32x4*)(bufB + (tok + 1) * 1536 + col);
                    const f32x4 w0a = *(const f32x4*)(cw + col), w0b = *(const f32x4*)(cw + col + 4), w1a = *(const f32x4*)(cw + 1536 + col), w1b = *(const f32x4*)(cw + 1536 + col + 4);
                    const f32x4 w2a = *(const f32x4*)(cw + 3072 + col), w2b = *(const f32x4*)(cw + 3072 + col + 4), ba = *(const f32x4*)(cb + col), bb = *(const f32x4*)(cb + col + 4);
                    const unsigned p0[4] = {u0.x, u0.y, u0.z, u0.w}, p1[4] = {u1.x, u1.y, u1.z, u1.w}, p2[4] = {u2.x, u2.y, u2.z, u2.w};
#pragma unroll
                    for (int j = 0; j < 4; ++j) { const float wl0 = j < 2 ? w0a[2 * j] : w0b[2 * j - 4], wh0 = j < 2 ? w0a[2 * j + 1] : w0b[2 * j - 3];
                        const float wl1 = j < 2 ? w1a[2 * j] : w1b[2 * j - 4], wh1 = j < 2 ? w1a[2 * j + 1] : w1b[2 * j - 3];
                        const float wl2 = j < 2 ? w2a[2 * j] : w2b[2 * j - 4], wh2 = j < 2 ? w2a[2 * j + 1] : w2b[2 * j - 3];
                        const float bl = j < 2 ? ba[2 * j] : bb[2 * j - 4], bh = j < 2 ? ba[2 * j + 1] : bb[2 * j - 3];
                        cv[grp][2 * j] = wl0 * bflo(p0[j]) + wl1 * bflo(p1[j]) + wl2 * bflo(p2[j]) + bl;
                        cv[grp][2 * j + 1] = wh0 * bfhi(p0[j]) + wh1 * bfhi(p1[j]) + wh2 * bfhi(p2[j]) + bh; } }
#pragma unroll
                for (int j = 0; j < 8; ++j) tile[(c0l + j) * 72 + tl] = f2bf(cv[0][j] * cv[1][j]);
                __syncthreads();
                tr_store(tile, zT, (size_t)(cb_ * 64) * 8 + b, 8, tb * 64);
                __syncthreads(); continue; }
            r -= NZ;
            if (r < NA) { const int cb_ = r & 3, tb = (r >> 2) & 31, b = r >> 7;
                const u32x4 v = *(const u32x4*)(bufA + ((size_t)b * T + tb * 64 + tl) * 1536 + 1280 + cb_ * 64 + c0l);
                const unsigned pv[4] = {v.x, v.y, v.z, v.w};
#pragma unroll
                for (int j = 0; j < 4; ++j) { tile[(c0l + 2 * j) * 72 + tl] = (bf16_t)(pv[j] & 0xffffu); tile[(c0l + 2 * j + 1) * 72 + tl] = (bf16_t)(pv[j] >> 16); }
                __syncthreads();
                tr_store(tile, vta, (size_t)b * 256 + cb_ * 64, 1, tb * 64);
                __syncthreads(); continue; }
            r -= NA;
            { const int cb_ = r & 7, tb = (r >> 3) & 31, b = r >> 8;
                const u32x4 v = *(const u32x4*)(bufD + ((size_t)b * T + tb * 64 + tl) * 1536 + 1024 + cb_ * 64 + c0l);
                const unsigned pv[4] = {v.x, v.y, v.z, v.w};
#pragma unroll
                for (int j = 0; j < 4; ++j) { tile[(c0l + 2 * j) * 72 + tl] = (bf16_t)(pv[j] & 0xffffu); tile[(c0l + 2 * j + 1) * 72 + tl] = (bf16_t)(pv[j] >> 16); }
                __syncthreads();
                tr_store(tile, vtd, (size_t)b * 512 + cb_ * 64, 1, tb * 64);
                __syncthreads(); }
        }
    }
}
__device__ __forceinline__ void scan_item(const Args& a, unsigned char* smem, int l, int item) {
    unsigned char* wsl = launder_ws(a.ws);
    int tid = threadIdx.x; asm volatile("" : "+v"(tid));
    const int dir = item & 1, h = (item >> 1) & 7, b = item >> 4;
    constexpr int BUFSZ = 7 * 1024 + 16;
    float* lds = (float*)smem;
    const bf16_t* bufC = (const bf16_t*)(wsl + OFF_BUFC);
    const bf16_t* sla = (const bf16_t*)(wsl + OFF_SLD) + (size_t)dir * M * 1024;
    bf16_t* oc = (bf16_t*)(wsl + OFF_OCDIR) + (size_t)dir * M * 512;
    const bool is_prod = tid >= 256;
    const int t8 = tid & 255, lane = tid & 63;
    const int pt0 = t8 >> 5, kp = t8 & 31, colr = h * 64 + 2 * kp;
    float w00 = 0.f, w01 = 0.f, a00 = 0.f, a01 = 0.f, mur0 = 0.f, mur1 = 0.f, muk0 = 0.f, muk1 = 0.f, muv0 = 0.f, muv1 = 0.f, kk0 = 0.f, kk1 = 0.f, ka0 = 0.f, ka1 = 0.f, rk0 = 0.f, rk1 = 0.f, lw0 = 0.f, lw1 = 0.f, lb0 = 0.f, lb1 = 0.f;
    if (is_prod) {
        w00 = a.in[17][(l * 2 + dir) * 512 + colr]; w01 = a.in[17][(l * 2 + dir) * 512 + colr + 1];
        a00 = a.in[19][(l * 2 + dir) * 512 + colr]; a01 = a.in[19][(l * 2 + dir) * 512 + colr + 1];
        const float* mu = a.in[16] + (size_t)(l * 2 + dir) * 1728;
        mur0 = mu[colr]; mur1 = mu[colr + 1]; muk0 = mu[512 + colr]; muk1 = mu[512 + colr + 1]; muv0 = mu[1024 + colr]; muv1 = mu[1024 + colr + 1];
        kk0 = a.in[22][l * 512 + colr]; kk1 = a.in[22][l * 512 + colr + 1]; ka0 = a.in[23][l * 512 + colr]; ka1 = a.in[23][l * 512 + colr + 1];
        rk0 = a.in[24][l * 512 + colr]; rk1 = a.in[24][l * 512 + colr + 1];
        lw0 = a.in[25][l * 512 + colr]; lw1 = a.in[25][l * 512 + colr + 1]; lb0 = a.in[26][l * 512 + colr]; lb1 = a.in[26][l * 512 + colr + 1];
    }
    const int cvp = t8 >> 3, ks = t8 & 7;
    typedef float f32x2s __attribute__((ext_vector_type(2)));
    f32x2s S2[8];
#pragma unroll
    for (int j = 0; j < 8; ++j) S2[j] = (f32x2s){0.f, 0.f};
    unsigned xr[2], xk[2], xv[2], sr[2], sk[2], sv[2], xl[2], xa[2];
#define SCAN_LOAD(c) do { _Pragma("unroll") for (int pp = 0; pp < 2; ++pp) { const int s_ = (c) * 16 + pt0 + 8 * pp; const int t_ = dir ? (T - 1 - s_) : s_; const int ts_ = dir ? t_ + 1 : t_ - 1; const size_t tok_ = (size_t)b * T + t_; \
        const bf16_t* p_ = bufC + tok_ * 2048 + colr; xr[pp] = *(const unsigned*)p_; xk[pp] = *(const unsigned*)(p_ + 512); xv[pp] = *(const unsigned*)(p_ + 1024); \
        sr[pp] = 0u; sk[pp] = 0u; sv[pp] = 0u; if (ts_ >= 0 && ts_ < T) { const bf16_t* q_ = bufC + ((size_t)b * T + ts_) * 2048 + colr; sr[pp] = *(const unsigned*)q_; sk[pp] = *(const unsigned*)(q_ + 512); sv[pp] = *(const unsigned*)(q_ + 1024); } \
        xl[pp] = *(const unsigned*)(sla + tok_ * 1024 + colr); xa[pp] = *(const unsigned*)(sla + tok_ * 1024 + 512 + colr); } } while (0)
#define SCAN_PRODUCE(bufp) do { float* R_ = (bufp); float* W_ = R_ + 1024; float* K_ = W_ + 1024; float* A_ = K_ + 1024; float* B_ = A_ + 1024; float* V_ = B_ + 1024; float* SB_ = V_ + 2048; \
        _Pragma("unroll") for (int pp = 0; pp < 2; ++pp) { const int ptl = pt0 + 8 * pp; \
            const float r0 = bflo(xr[pp]) + (bflo(sr[pp]) - bflo(xr[pp])) * mur0, r1 = bfhi(xr[pp]) + (bfhi(sr[pp]) - bfhi(xr[pp])) * mur1; \
            const float k0 = bflo(xk[pp]) + (bflo(sk[pp]) - bflo(xk[pp])) * muk0, k1 = bfhi(xk[pp]) + (bfhi(sk[pp]) - bfhi(xk[pp])) * muk1; \
            const float v0 = bflo(xv[pp]) + (bflo(sv[pp]) - bflo(xv[pp])) * muv0, v1 = bfhi(xv[pp]) + (bfhi(sv[pp]) - bfhi(xv[pp])) * muv1; \
            const float a0 = sigmoidf_(a00 + bflo(xa[pp])), a1 = sigmoidf_(a01 + bfhi(xa[pp])); \
            const float q0 = k0 * kk0, q1 = k1 * kk1; \
            const float ss = half_sum(q0 * q0 + q1 * q1, lane); \
            const float inv = 1.f / fmaxf(sqrtf(ss), 1e-12f); \
            const float n0 = q0 * inv, n1 = q1 * inv; \
            const float kn0 = k0 * (1.f + (a0 - 1.f) * ka0), kn1 = k1 * (1.f + (a1 - 1.f) * ka1); \
            const float sb = half_sum(r0 * kn0 * rk0 + r1 * kn1 * rk1, lane); \
            const int o = ptl * 64 + 2 * kp; \
            *(float2*)(R_ + o) = make_float2(r0, r1); \
            *(float2*)(W_ + o) = make_float2(__expf(-0.60653065971f * sigmoidf_(w00 + bflo(xl[pp]))), __expf(-0.60653065971f * sigmoidf_(w01 + bfhi(xl[pp])))); \
            *(float2*)(K_ + o) = make_float2(kn0, kn1); \
            *(float2*)(A_ + o) = make_float2(-n0, -n1); \
            *(float2*)(B_ + o) = make_float2(n0 * a0, n1 * a1); \
            *(float2*)(V_ + o) = make_float2(v0, v1); \
            if (kp == 0) SB_[ptl] = sb; } } while (0)
    if (is_prod) { SCAN_LOAD(0); SCAN_PRODUCE(lds); SCAN_LOAD(1); }
    __syncthreads();
    for (int c = 0; c < 128; ++c) {
        float* cur = lds + (c & 1) * BUFSZ; float* oth = lds + ((c & 1) ^ 1) * BUFSZ;
        if (!is_prod) {
            const float* R = cur; const float* W = R + 1024; const float* Kx = W + 1024; const float* Ax = Kx + 1024; const float* Bx = Ax + 1024; const float* Vx = Bx + 1024; float* Ox = cur + 6 * 1024;
#define SC_DECL(P) f32x4 P##a0, P##a1, P##w0, P##w1, P##b0, P##b1, P##k0, P##k1, P##r0, P##r1; float2 P##vv
#define SC_LOAD(P, tl) do { P##vv = *(const float2*)(Vx + (tl) * 64 + 2 * cvp); \
                P##a0 = *(const f32x4*)(Ax + (tl) * 64 + ks * 8); P##a1 = *(const f32x4*)(Ax + (tl) * 64 + ks * 8 + 4); \
                P##w0 = *(const f32x4*)(W + (tl) * 64 + ks * 8); P##w1 = *(const f32x4*)(W + (tl) * 64 + ks * 8 + 4); \
                P##b0 = *(const f32x4*)(Bx + (tl) * 64 + ks * 8); P##b1 = *(const f32x4*)(Bx + (tl) * 64 + ks * 8 + 4); \
                P##k0 = *(const f32x4*)(Kx + (tl) * 64 + ks * 8); P##k1 = *(const f32x4*)(Kx + (tl) * 64 + ks * 8 + 4); \
                P##r0 = *(const f32x4*)(R + (tl) * 64 + ks * 8); P##r1 = *(const f32x4*)(R + (tl) * 64 + ks * 8 + 4); } while (0)
#define SC_STEP(P, tl) do { \
                f32x2s sa = (S2[0] * P##a0[0] + S2[1] * P##a0[1]) + (S2[2] * P##a0[2] + S2[3] * P##a0[3]); \
                f32x2s sb_ = (S2[4] * P##a1[0] + S2[5] * P##a1[1]) + (S2[6] * P##a1[2] + S2[7] * P##a1[3]); \
                sa = sa + sb_; \
                sa.x = sum8(sa.x); sa.y = sum8(sa.y); \
                const f32x2s vv2 = {P##vv.x, P##vv.y}; \
                _Pragma("unroll") for (int j = 0; j < 4; ++j) { \
                    S2[j] = S2[j] * P##w0[j] + (sa * P##b0[j] + vv2 * P##k0[j]); S2[4 + j] = S2[4 + j] * P##w1[j] + (sa * P##b1[j] + vv2 * P##k1[j]); } \
                f32x2s oo = (S2[0] * P##r0[0] + S2[1] * P##r0[1]) + (S2[2] * P##r0[2] + S2[3] * P##r0[3]); \
                f32x2s ob_ = (S2[4] * P##r1[0] + S2[5] * P##r1[1]) + (S2[6] * P##r1[2] + S2[7] * P##r1[3]); \
                oo = oo + ob_; \
                oo.x = sum8(oo.x); oo.y = sum8(oo.y); \
                if (ks == 0) *(float2*)(Ox + (tl) * 64 + 2 * cvp) = make_float2(oo.x, oo.y); } while (0)
            SC_DECL(pa_); SC_DECL(pb_);
            SC_LOAD(pa_, 0);
#pragma unroll 1
            for (int tl = 0; tl < 16; tl += 2) {
                SC_LOAD(pb_, tl + 1);
                SC_STEP(pa_, tl);
                if (tl + 2 < 16) SC_LOAD(pa_, tl + 2);
                SC_STEP(pb_, tl + 1);
            }
#undef SC_DECL
#undef SC_LOAD
#undef SC_STEP
        } else {
            if (c > 0) {
                const float* Ox = oth + 6 * 1024; const float* Vx = oth + 5 * 1024; const float* SB = oth + 7 * 1024;
#pragma unroll
                for (int pp = 0; pp < 2; ++pp) { const int ptl = pt0 + 8 * pp;
                    const float2 ov = *(const float2*)(Ox + ptl * 64 + 2 * kp);
                    const float mean = half_sum(ov.x + ov.y, lane) * (1.f / 64.f);
                    const float d0 = ov.x - mean, d1 = ov.y - mean;
                    const float var = half_sum(d0 * d0 + d1 * d1, lane) * (1.f / 64.f);
                    const float rs = rsqrtf(var + 64e-5f);
                    const float2 vv = *(const float2*)(Vx + ptl * 64 + 2 * kp); const float sb = SB[ptl];
                    const float y0 = d0 * rs * lw0 + lb0 + sb * vv.x, y1 = d1 * rs * lw1 + lb1 + sb * vv.y;
                    const int s_ = (c - 1) * 16 + ptl; const int t_ = dir ? (T - 1 - s_) : s_;
                    *(unsigned*)(oc + ((size_t)b * T + t_) * 512 + colr) = pk2(y0, y1); }
            }
            if (c + 1 < 128) { SCAN_PRODUCE(oth); if (c + 2 < 128) SCAN_LOAD(c + 2); }
        }
        __syncthreads();
    }
    if (is_prod) {
        const float* fin = lds + (127 & 1) * BUFSZ; const float* Ox = fin + 6 * 1024; const float* Vx = fin + 5 * 1024; const float* SB = fin + 7 * 1024;
#pragma unroll
        for (int pp = 0; pp < 2; ++pp) { const int ptl = pt0 + 8 * pp;
            const float2 ov = *(const float2*)(Ox + ptl * 64 + 2 * kp);
            const float mean = half_sum(ov.x + ov.y, lane) * (1.f / 64.f);
            const float d0 = ov.x - mean, d1 = ov.y - mean;
            const float var = half_sum(d0 * d0 + d1 * d1, lane) * (1.f / 64.f);
            const float rs = rsqrtf(var + 64e-5f);
            const float2 vv = *(const float2*)(Vx + ptl * 64 + 2 * kp); const float sb = SB[ptl];
            const float y0 = d0 * rs * lw0 + lb0 + sb * vv.x, y1 = d1 * rs * lw1 + lb1 + sb * vv.y;
            const int s_ = 127 * 16 + ptl; const int t_ = dir ? (T - 1 - s_) : s_;
            *(unsigned*)(oc + ((size_t)b * T + t_) * 512 + colr) = pk2(y0, y1); }
    }
    __syncthreads();
#undef SCAN_LOAD
#undef SCAN_PRODUCE
}
template <int DQK, int MODE>
__device__ __forceinline__ void attn_item(unsigned char* smem, const bf16_t* Q, int ldq, const bf16_t* Kg, int ldk, const bf16_t* Vt, float sc, float slope, int q0,
                                          bf16_t* O, int ldo, float lam, const float* subln, float outmul) {
    constexpr int KST = DQK * 2 + 16, VST = 144, KBYTES = 64 * KST, VBYTES = 128 * VST, NKK = DQK / 16, KCH = DQK / 8, KLD = KCH / 8;
    int tid = threadIdx.x; asm volatile("" : "+v"(tid));
    const int lane = tid & 63, wave = tid >> 6, r = lane & 31, h = lane >> 5;
#define Kb_(x) (smem + (x) * KBYTES)
#define Vb_(x) (smem + 2 * KBYTES + (x) * VBYTES)
    bf16x8 qf[NKK];
    { const bf16_t* qp = Q + (size_t)(wave * 32 + r) * ldq + 8 * h;
#pragma unroll
      for (int kk = 0; kk < NKK; ++kk) { const u32x4 qv = *(const u32x4*)(qp + 16 * kk); u32x4 w;
          w.x = pk2(bflo(qv.x) * sc, bfhi(qv.x) * sc); w.y = pk2(bflo(qv.y) * sc, bfhi(qv.y) * sc); w.z = pk2(bflo(qv.z) * sc, bfhi(qv.z) * sc); w.w = pk2(bflo(qv.w) * sc, bfhi(qv.w) * sc);
          qf[kk] = __builtin_bit_cast(bf16x8, w); } }
    f32x16 o[4];
#pragma unroll
    for (int i = 0; i < 4; ++i)
#pragma unroll
        for (int j = 0; j < 16; ++j) o[i][j] = 0.f;
    float m_run = -1e30f, l_run = 0.f;
    u32x4 kreg[2];
#define ATT_LOADK(kt) do { _Pragma("unroll") for (int i_ = 0; i_ < KLD; ++i_) { const int id_ = tid + 512 * i_, row_ = id_ / KCH, ch_ = id_ % KCH; kreg[i_] = *(const u32x4*)(Kg + (size_t)((kt) * 64 + row_) * ldk + ch_ * 8); } } while (0)
#define ATT_LOADV(kt) do { _Pragma("unroll") for (int i_ = 0; i_ < 2; ++i_) { const int id_ = tid + 512 * i_, row_ = id_ >> 3, ch_ = id_ & 7; kreg[i_] = *(const u32x4*)(Vt + (size_t)row_ * T + (kt) * 64 + ch_ * 8); } } while (0)
#define ATT_STOREK(bi) do { _Pragma("unroll") for (int i_ = 0; i_ < KLD; ++i_) { const int id_ = tid + 512 * i_, row_ = id_ / KCH, ch_ = id_ % KCH; *(u32x4*)(Kb_(bi) + row_ * KST + ch_ * 16) = kreg[i_]; } } while (0)
#define ATT_STOREV(bi) do { _Pragma("unroll") for (int i_ = 0; i_ < 2; ++i_) { const int id_ = tid + 512 * i_, row_ = id_ >> 3, ch_ = id_ & 7; *(u32x4*)(Vb_(bi) + row_ * VST + ch_ * 16) = kreg[i_]; } } while (0)
    __syncthreads();
    ATT_LOADK(0); ATT_STOREK(0); ATT_LOADV(0); ATT_STOREV(0);
    __syncthreads();
    const int qpos = q0 + wave * 32 + r;
    for (int kt = 0; kt < 32; ++kt) {
        const int bi = kt & 1;
#pragma unroll
        for (int kb = 0; kb < 2; ++kb) {
            if (kt + 1 < 32) { if (kb == 0) ATT_LOADK(kt + 1); else { ATT_STOREK(bi ^ 1); ATT_LOADV(kt + 1); } }
            f32x16 s;
#pragma unroll
            for (int j = 0; j < 16; ++j) s[j] = 0.f;
#pragma unroll
            for (int kk = 0; kk < NKK; ++kk) { const bf16x8 af = *(const bf16x8*)(Kb_(bi) + (32 * kb + r) * KST + (16 * kk + 8 * h) * 2);
                s = __builtin_amdgcn_mfma_f32_32x32x16_bf16(af, qf[kk], s, 0, 0, 0); }
            float mt = -1e30f;
            if (slope != 0.f) { const float dq = (float)(qpos - kt * 64 - 4 * h - 32 * kb);
#pragma unroll
                for (int j = 0; j < 16; ++j) { const float dd = dq - (float)((j & 3) + 8 * (j >> 2)); s[j] = fmaf(-slope, fabsf(dd), s[j]); mt = fmaxf(mt, s[j]); }
            } else {
#pragma unroll
                for (int j = 0; j < 16; ++j) mt = fmaxf(mt, s[j]);
            }
            mt = fmaxf(mt, shx(mt, 32, lane));
            const float m_new = fmaxf(m_run, mt), alpha = __builtin_amdgcn_exp2f(m_run - m_new);
            m_run = m_new;
            float psum = 0.f;
#pragma unroll
            for (int j = 0; j < 16; ++j) { s[j] = __builtin_amdgcn_exp2f(s[j] - m_new); psum += s[j]; }
            l_run = l_run * alpha + psum;
            if (__builtin_amdgcn_ballot_w64(alpha != 1.0f) != 0ull) {
#pragma unroll
                for (int i = 0; i < 4; ++i) o[i] = o[i] * alpha; }
            bf16x8 pf[2];
#pragma unroll
            for (int s2 = 0; s2 < 2; ++s2) { u32x4 w; w.x = pk2(s[8 * s2 + 0], s[8 * s2 + 1]); w.y = pk2(s[8 * s2 + 2], s[8 * s2 + 3]);
                w.z = pk2(s[8 * s2 + 4], s[8 * s2 + 5]); w.w = pk2(s[8 * s2 + 6], s[8 * s2 + 7]); pf[s2] = __builtin_bit_cast(bf16x8, w); }
#pragma unroll
            for (int dvb = 0; dvb < 4; ++dvb)
#pragma unroll
                for (int s2 = 0; s2 < 2; ++s2) { const unsigned char* vp = Vb_(bi) + (32 * dvb + r) * VST + (32 * kb + 16 * s2 + 4 * h) * 2;
                    const u32x2 lo = *(const u32x2*)vp, hi = *(const u32x2*)(vp + 16); u32x4 w; w.x = lo.x; w.y = lo.y; w.z = hi.x; w.w = hi.y;
                    o[dvb] = __builtin_amdgcn_mfma_f32_32x32x16_bf16(__builtin_bit_cast(bf16x8, w), pf[s2], o[dvb], 0, 0, 0); }
        }
        if (kt + 1 < 32) ATT_STOREV(bi ^ 1);
        __syncthreads();
    }
#undef ATT_LOADK
#undef ATT_LOADV
#undef ATT_STOREK
#undef ATT_STOREV
#undef Kb_
#undef Vb_
    const float lt = l_run + shx(l_run, 32, lane), inv = 1.f / lt;
    bf16_t* orow = O + (size_t)(wave * 32 + r) * ldo;
    unsigned char* stash = smem + 73728 + tid * 128;
    if (MODE == 0) {
#pragma unroll
        for (int dvb = 0; dvb < 4; ++dvb)
#pragma unroll
            for (int g = 0; g < 4; ++g) { u32x2 w; w.x = pk2(o[dvb][4 * g] * inv, o[dvb][4 * g + 1] * inv); w.y = pk2(o[dvb][4 * g + 2] * inv, o[dvb][4 * g + 3] * inv);
                *(u32x2*)(orow + 32 * dvb + 8 * g + 4 * h) = w; }
    } else if (MODE == 1) {
#pragma unroll
        for (int dvb = 0; dvb < 4; ++dvb)
#pragma unroll
            for (int g = 0; g < 4; ++g) { u32x2 w; w.x = pk2(o[dvb][4 * g] * inv, o[dvb][4 * g + 1] * inv); w.y = pk2(o[dvb][4 * g + 2] * inv, o[dvb][4 * g + 3] * inv);
                *(u32x2*)(stash + (4 * dvb + g) * 8) = w; }
    } else {
        float ss = 0.f;
#pragma unroll
        for (int dvb = 0; dvb < 4; ++dvb)
#pragma unroll
            for (int g = 0; g < 4; ++g) { const u32x2 pv = *(const u32x2*)(stash + (4 * dvb + g) * 8);
                o[dvb][4 * g] = bflo(pv.x) - lam * o[dvb][4 * g] * inv; o[dvb][4 * g + 1] = bfhi(pv.x) - lam * o[dvb][4 * g + 1] * inv;
                o[dvb][4 * g + 2] = bflo(pv.y) - lam * o[dvb][4 * g + 2] * inv; o[dvb][4 * g + 3] = bfhi(pv.y) - lam * o[dvb][4 * g + 3] * inv;
#pragma unroll
                for (int j = 0; j < 4; ++j) ss += o[dvb][4 * g + j] * o[dvb][4 * g + j]; }
        ss += shx(ss, 32, lane);
        const float rs = rsqrtf(ss * (1.f / 128.f) + 1e-6f) * outmul;
#pragma unroll
        for (int dvb = 0; dvb < 4; ++dvb)
#pragma unroll
            for (int g = 0; g < 4; ++g) { const f32x4 gv = *(const f32x4*)(subln + 32 * dvb + 8 * g + 4 * h); u32x2 w;
                w.x = pk2(o[dvb][4 * g] * rs * gv[0], o[dvb][4 * g + 1] * rs * gv[1]); w.y = pk2(o[dvb][4 * g + 2] * rs * gv[2], o[dvb][4 * g + 3] * rs * gv[3]);
                *(u32x2*)(orow + 32 * dvb + 8 * g + 4 * h) = w; }
    }
}
__device__ __forceinline__ void hyena_item(const Args& a, unsigned char* smem, int l, int c) {
    unsigned char* wsl = launder_ws(a.ws);
    constexpr int CST = 4112;
    int tid = threadIdx.x; asm volatile("" : "+v"(tid));
    const int lane = tid & 63, wave = tid >> 6;
    float* HF = (float*)smem; float* HB = HF + 2048; float* red = HB + 2048;
    float* w4s = red + 16;
    bf16_t* E = (bf16_t*)(smem + 16384 + 1024);
    bf16_t* zs = E + 8 * CST;
    constexpr int ZST = 2056;
    const float* hid3 = (const float*)(wsl + OFF_HID3) + (size_t)l * 2048 * 64;
    const float* w4 = a.in[13] + (size_t)l * 64 * 1024;
    __syncthreads();
    if (tid < 128) w4s[tid] = w4[(tid & 63) * 1024 + (tid >> 6) * 512 + c];
    __syncthreads();
    const float delta = fabsf(-3.0701134573253946f + (-15.350567286626972f + 3.0701134573253946f) * ((float)c / 511.f));
    float asum = 0.f;
#pragma unroll 1
    for (int rr = 0; rr < 4; ++rr) { const int j = tid + 512 * rr; const f32x4* hp = (const f32x4*)(hid3 + (size_t)j * 64);
        float f = 0.f, bk = 0.f;
#pragma unroll
        for (int q = 0; q < 16; ++q) { const f32x4 hv = hp[q];
#pragma unroll
            for (int e = 0; e < 4; ++e) { f += hv[e] * w4s[4 * q + e]; bk += hv[e] * w4s[64 + 4 * q + e]; } }
        const float win = __expf(-((float)j / 2047.f) * delta);
        f *= win; bk *= win; HF[j] = f; HB[j] = bk; asum += fabsf(f) + (j > 0 ? fabsf(bk) : 0.f); }
    asum = wave_sum(asum, lane);
    if (lane == 0) red[wave] = asum;
    { const bf16_t* zT = (const bf16_t*)(wsl + OFF_ZT) + (size_t)c * 8 * 2048;
#pragma unroll
      for (int i = 0; i < 4; ++i) { const int id = tid + 512 * i, bb = id >> 8, ch = id & 255; *(u32x4*)(zs + bb * ZST + ch * 8) = *(const u32x4*)(zT + (size_t)bb * 2048 + ch * 8); } }
    __syncthreads();
    float tot = 0.f;
#pragma unroll
    for (int i = 0; i < 8; ++i) tot += red[i];
    const float invn = 1.f / tot;
    for (int idx = tid; idx < 8 * 4096; idx += NTHR) { const int u = idx >> 12, ip = idx & 4095, i = ip - u; float v = 0.f;
        if (i >= 1 && i <= 4095) { const int d = 2048 - i; v = (d >= 0 ? HF[d] : HB[-d]) * invn; }
        E[u * CST + ip] = f2bf(v); }
    __syncthreads();
    float* yT = (float*)(wsl + OFF_YT) + (size_t)c * 8 * 2048;
    const int m = lane & 15, q = lane >> 4;
    const bf16_t* Eu = E + (m & 7) * CST + 2048 + 8 * q - (m & 8);
    const bf16_t* zrow = zs + (m & 7) * ZST + 8 * q;
#pragma unroll 1
    for (int g = 0; g < 4; ++g) {
        const int tt0 = wave * 16 + g * 4;
        f32x4 acc[4];
#pragma unroll
        for (int i = 0; i < 4; ++i) acc[i] = (f32x4){0.f, 0.f, 0.f, 0.f};
#pragma unroll 2
        for (int ss = 0; ss < 64; ++ss) { const int s0 = ss * 32;
            bf16x8 bz = *(const bf16x8*)(zrow + s0);
            if (m >= 8) bz = (bf16x8){0, 0, 0, 0, 0, 0, 0, 0};
#pragma unroll
            for (int i = 0; i < 4; ++i) { const bf16x8 af = *(const bf16x8*)(Eu - (tt0 + i) * 16 + s0);
                acc[i] = __builtin_amdgcn_mfma_f32_16x16x32_bf16(af, bz, acc[i], 0, 0, 0); } }
        if (m < 8) {
#pragma unroll
            for (int i = 0; i < 4; ++i) *(f32x4*)(yT + (size_t)m * 2048 + (tt0 + i) * 16 + 4 * q) = acc[i]; }
    }
    __syncthreads();
}
#if defined(DBG_STOP)
#ifndef PH_MASK
#define PH_MASK ((2 << (DBG_STOP >= 40 ? 4 : DBG_STOP)) - 1)
#endif
#define DBG_LAYERS 1
#ifndef DBG_NL
#define DBG_NL 1
#endif
#define NLAYER DBG_NL
#else
#define NLAYER 2
#endif
#ifndef PH_MASK
#define PH_MASK 0xFFF
#endif
#ifndef PH_MASK0
#define PH_MASK0 0xFFF
#endif
#ifndef PH_DUP
#define PH_DUP 0
#endif
__device__ __forceinline__ void mixers_phase(const Args& a, unsigned char* smem, int l) {
    unsigned char* wsl = launder_ws(a.ws); const int bid_ = lbid();
    constexpr int N_SCAN = 128, N_D = 256, N_A = 512, N_H = 512, N_W8 = 44 * 32 + 8 * 88, N_W0 = 32 * 32 + 8 * 16 + 3 * 8 * 8 + 8 * 32, N_ALL = N_SCAN + 4 * (N_D + N_A + N_H);
    static_assert(3 * (N_D + N_A + N_H) >= N_W8 + N_W0, "memory item slots");
    unsigned* ctr = (unsigned*)(wsl + OFF_CTL) + 64 * (1 + l);
    int* sh = (int*)(smem + LDS_BYTES - 16);
    const float LOG2E = 1.4426950408889634f;
    for (;;) {
        __syncthreads();
        if (ltid() == 0) sh[0] = (int)atomicAdd(ctr, 1u);
        __syncthreads();
        const int it = __builtin_amdgcn_readfirstlane(sh[0]);
        if (it >= N_ALL) break;
        if (it < N_SCAN) { scan_item(a, smem, l, it); continue; }
        const int q = it - N_SCAN, grp = q >> 2, j = q & 3;
        if (j < 3) {
            const int m = grp * 3 + j;
            if (m >= N_W8 + N_W0) continue;
            const WItem w = m < N_W8 ? witem_phase8(wsl, m) : witem_phase0(wsl, 26 * 32 + (m - N_W8)); float rg[32];
            witem_load(a, l, w, rg); witem_tolds((float*)smem, rg);
            __syncthreads();
            witem_store(w, (const float*)smem);
            continue;
        }
        int r = grp;
        if (r < N_D) {
            const int qb = r & 7, hd = (r >> 3) & 3, b = r >> 5;
            const bf16_t* bufD = (const bf16_t*)(wsl + OFF_BUFD) + (size_t)b * T * 1536;
            const bf16_t* vt = (const bf16_t*)(wsl + OFF_VTD) + ((size_t)b * 512 + hd * 128) * T;
            bf16_t* od = (bf16_t*)(wsl + OFF_OD) + ((size_t)b * T + qb * 256) * 512 + hd * 128;
            const float slope = exp2f(-2.f * (float)(hd + 1)) * LOG2E, sc = 0.125f * LOG2E;
            const float lam = ((const float*)(wsl + OFF_LAM))[l];
            const float lam_init = 0.8f - 0.6f * expf(-0.3f * (float)l);
            attn_item<64, 1>(smem, bufD + (size_t)qb * 256 * 1536 + hd * 128, 1536, bufD + 512 + hd * 128, 1536, vt, sc, slope, qb * 256, od, 512, 0.f, nullptr, 1.f);
            attn_item<64, 2>(smem, bufD + (size_t)qb * 256 * 1536 + hd * 128 + 64, 1536, bufD + 512 + hd * 128 + 64, 1536, vt, sc, slope, qb * 256, od, 512, lam, a.in[31] + l * 128, 1.f - lam_init);
            continue; }
        r -= N_D;
        if (r < N_A) {
            const int qb = r & 7, hq = (r >> 3) & 7, b = r >> 6, hkv = hq >> 2;
            const bf16_t* bufA = (const bf16_t*)(wsl + OFF_BUFA) + (size_t)b * T * 1536;
            const bf16_t* vt = (const bf16_t*)(wsl + OFF_VTA) + ((size_t)b * 256 + hkv * 128) * T;
            bf16_t* oa = (bf16_t*)(wsl + OFF_OA) + ((size_t)b * T + qb * 256) * 1024 + hq * 128;
            attn_item<128, 0>(smem, bufA + (size_t)qb * 256 * 1536 + hq * 128, 1536, bufA + 1024 + hkv * 128, 1536, vt, 0.08838834764831845f * LOG2E, 0.f, qb * 256, oa, 1024, 0.f, nullptr, 1.f);
            continue; }
        r -= N_A;
        hyena_item(a, smem, l, r);
    }
}
__device__ __forceinline__ void post_phase(const Args& a, unsigned char* smem, int l) {
    unsigned char* wsl = launder_ws(a.ws); const int bid_ = lbid();
    const int tid = ltid();
    const bf16_t* bufB = (const bf16_t*)(wsl + OFF_BUFB);
    const float* yT = (const float*)(wsl + OFF_YT);
    bf16_t* ob = (bf16_t*)(wsl + OFF_OB);
    const float* cw = a.in[5] + (size_t)l * 3 * 1536; const float* cb = a.in[6] + (size_t)l * 1536; const float* skip = a.in[15] + l * 512;
    float* Y = (float*)smem;
    for (int it = bid_; it < 8 * 32 * 8; it += gridDim.x) {
        const int cb_ = it & 7, tb = (it >> 3) & 31, b = it >> 8;
        { const int cl = tid >> 3, tch = tid & 7; const float* yp = yT + ((size_t)(cb_ * 64 + cl) * 8 + b) * 2048 + tb * 64 + tch * 8;
          const f32x4 y0 = *(const f32x4*)yp, y1 = *(const f32x4*)(yp + 4); float* d = Y + cl * 65 + tch * 8;
          d[0] = y0[0]; d[1] = y0[1]; d[2] = y0[2]; d[3] = y0[3]; d[4] = y1[0]; d[5] = y1[1]; d[6] = y1[2]; d[7] = y1[3]; }
        __syncthreads();
        {
            const int tl = tid >> 3, c0 = cb_ * 64 + (tid & 7) * 8, t = tb * 64 + tl; const size_t tok = (size_t)b * T + t;
            float cv[3][8];
#pragma unroll
            for (int grp = 0; grp < 3; ++grp) { const int col = grp * 512 + c0;
                const u32x4 u1 = *(const u32x4*)(bufB + tok * 1536 + col);
                u32x4 u0 = {0u, 0u, 0u, 0u}, u2 = {0u, 0u, 0u, 0u};
                if (t > 0) u0 = *(const u32x4*)(bufB + (tok - 1) * 1536 + col);
                if (t < T - 1) u2 = *(const u32x4*)(bufB + (tok + 1) * 1536 + col);
                const f32x4 w0a = *(const f32x4*)(cw + col), w0b = *(const f32x4*)(cw + col + 4), w1a = *(const f32x4*)(cw + 1536 + col), w1b = *(const f32x4*)(cw + 1536 + col + 4);
                const f32x4 w2a = *(const f32x4*)(cw + 3072 + col), w2b = *(const f32x4*)(cw + 3072 + col + 4), ba = *(const f32x4*)(cb + col), bb = *(const f32x4*)(cb + col + 4);
                const unsigned p0[4] = {u0.x, u0.y, u0.z, u0.w}, p1[4] = {u1.x, u1.y, u1.z, u1.w}, p2[4] = {u2.x, u2.y, u2.z, u2.w};
#pragma unroll
                for (int j = 0; j < 4; ++j) { const float wl0 = j < 2 ? w0a[2 * j] : w0b[2 * j - 4], wh0 = j < 2 ? w0a[2 * j + 1] : w0b[2 * j - 3];
                    const float wl1 = j < 2 ? w1a[2 * j] : w1b[2 * j - 4], wh1 = j < 2 ? w1a[2 * j + 1] : w1b[2 * j - 3];
                    const float wl2 = j < 2 ? w2a[2 * j] : w2b[2 * j - 4], wh2 = j < 2 ? w2a[2 * j + 1] : w2b[2 * j - 3];
                    const float bl = j < 2 ? ba[2 * j] : bb[2 * j - 4], bh = j < 2 ? ba[2 * j + 1] : bb[2 * j - 3];
                    cv[grp][2 * j] = wl0 * bflo(p0[j]) + wl1 * bflo(p1[j]) + wl2 * bflo(p2[j]) + bl;
                    cv[grp][2 * j + 1] = wh0 * bfhi(p0[j]) + wh1 * bfhi(p1[j]) + wh2 * bfhi(p2[j]) + bh; } }
            const f32x4 ska = *(const f32x4*)(skip + c0), skb = *(const f32x4*)(skip + c0 + 4);
            float o8[8];
#pragma unroll
            for (int j = 0; j < 8; ++j) { const float z = cv[0][j] * cv[1][j], sk = j < 4 ? ska[j] : skb[j - 4];
                o8[j] = (Y[((tid & 7) * 8 + j) * 65 + tl] + z * sk) * cv[2][j]; }
            u32x4 w; w.x = pk2(o8[0], o8[1]); w.y = pk2(o8[2], o8[3]); w.z = pk2(o8[4], o8[5]); w.w = pk2(o8[6], o8[7]);
            *(u32x4*)(ob + tok * 512 + c0) = w; }
        __syncthreads();
    }
    const bf16_t* oc0 = (const bf16_t*)(wsl + OFF_OCDIR); const bf16_t* oc1 = oc0 + (size_t)M * 512; const bf16_t* gb = (const bf16_t*)(wsl + OFF_GBUF);
    bf16_t* ocv = (bf16_t*)(wsl + OFF_OC);
    for (size_t i = (size_t)bid_ * NTHR + tid; i < (size_t)M * 512 / 8; i += (size_t)gridDim.x * NTHR) {
        const u32x4 x0 = *(const u32x4*)(oc0 + i * 8), x1 = *(const u32x4*)(oc1 + i * 8), g = *(const u32x4*)(gb + i * 8); u32x4 o;
        o.x = pk2((bflo(x0.x) + bflo(x1.x)) * bflo(g.x), (bfhi(x0.x) + bfhi(x1.x)) * bfhi(g.x));
        o.y = pk2((bflo(x0.y) + bflo(x1.y)) * bflo(g.y), (bfhi(x0.y) + bfhi(x1.y)) * bfhi(g.y));
        o.z = pk2((bflo(x0.z) + bflo(x1.z)) * bflo(g.z), (bfhi(x0.z) + bfhi(x1.z)) * bfhi(g.z));
        o.w = pk2((bflo(x0.w) + bflo(x1.w)) * bflo(g.w), (bfhi(x0.w) + bfhi(x1.w)) * bfhi(g.w));
        *(u32x4*)(ocv + i * 8) = o; }
}

#if defined(DBG_STOP)
__device__ __forceinline__ void dbg_dump(const Args& a, const bf16_t* b0, size_t n0, const bf16_t* b1, size_t n1, const bf16_t* b2, size_t n2, const bf16_t* b3, size_t n3) {
    for (size_t i = (size_t)lbid() * NTHR + ltid(); i < (size_t)M * D; i += (size_t)gridDim.x * NTHR)
    {   float v0 = bf2f(b0[i % n0]), v1 = bf2f(b1[i % n1]), v2 = bf2f(b2[i % n2]), v3 = DBG_STOP == 41 ? ((const float*)b3)[i % (n3 / 2)] : bf2f(b3[i % n3]);
        const bool bad = !(fabsf(v0) < 1e30f) || !(fabsf(v1) < 1e30f) || !(fabsf(v2) < 1e30f) || !(fabsf(v3) < 1e30f);
        a.out[i] = bad ? 1e9f : (v0 + v1 + v2 + v3) * 1e-3f; }
}
#define DBG_AT(k, B0, N0, B1, N1, B2, N2, B3, N3) if (DBG_STOP == (k)) { dbg_dump(a, (const bf16_t*)(ws + (B0)), (size_t)(N0), (const bf16_t*)(ws + (B1)), (size_t)(N1), (const bf16_t*)(ws + (B2)), (size_t)(N2), (const bf16_t*)(ws + (B3)), (size_t)(N3)); }
#else
#define DBG_AT(k, B0, N0, B1, N1, B2, N2, B3, N3)
#endif
#define PHASE_SYNC() do { xcd_barrier(xb); ws = launder_ws(a.ws); hbuf = (bf16_t*)(ws + OFF_H); } while (0)
template <int L> __device__ __forceinline__ void run_layer(const Args& a, unsigned char* smem, const XcdBarrier& xb) {
    constexpr int l = L;
    unsigned char* ws = launder_ws(a.ws);
    bf16_t* hbuf = (bf16_t*)(ws + OFF_H);
        ws = launder_ws(a.ws); hbuf = (bf16_t*)(ws + OFF_H);
#if defined(DBG_DELAY)
        if (l == 1) { for (int i = 0; i < 20000; ++i) __builtin_amdgcn_s_sleep(64); PHASE_SYNC(); }
#endif
        for (int rep_ = 0; rep_ < (((PH_DUP >> 0) & 1) ? 2 : 1); ++rep_) if (((l + 1 < NLAYER) ? PH_MASK0 : PH_MASK) & (1 << 0)) {
        if (rep_ > 0) { PHASE_SYNC(); }
        if (lbid() == 0 && ltid() == 0) ((unsigned*)(ws + OFF_CTL))[64 * (1 + l)] = 0u;
        wconv_phase0(a, smem, l);
        if (l == 0) hid3_and_lam(a);
        rmsnorm_rows<true>(l == 0 ? a.in[0] : a.out, a.in[1] + l * 2048, hbuf, nullptr);
        }
        PHASE_SYNC();
        for (int rep_ = 0; rep_ < (((PH_DUP >> 1) & 1) ? 2 : 1); ++rep_) if (((l + 1 < NLAYER) ? PH_MASK0 : PH_MASK) & (1 << 1)) {
        if (rep_ > 0) { PHASE_SYNC(); }
        { EpiIn e; e.bA = (bf16_t*)(ws + OFF_BUFA); e.bB = (bf16_t*)(ws + OFF_BUFB); e.bD = (bf16_t*)(ws + OFF_BUFD); e.bC = (bf16_t*)(ws + OFF_BUFC);
          run_gemm(smem, hbuf, (const bf16_t*)(ws + OFF_WIN), DINP, 2048, e); }
        }
        PHASE_SYNC();
        for (int rep_ = 0; rep_ < (((PH_DUP >> 2) & 1) ? 2 : 1); ++rep_) if (((l + 1 < NLAYER) ? PH_MASK0 : PH_MASK) & (1 << 2)) {
        if (rep_ > 0) { PHASE_SYNC(); }
        prep_phase(a, smem, l);
        }
        PHASE_SYNC();
        for (int rep_ = 0; rep_ < (((PH_DUP >> 3) & 1) ? 2 : 1); ++rep_) if (((l + 1 < NLAYER) ? PH_MASK0 : PH_MASK) & (1 << 3)) {
        if (rep_ > 0) { PHASE_SYNC(); }
#pragma unroll 1
        for (int d = 0; d < 2; ++d) { EpiBf e; e.O = (bf16_t*)(ws + OFF_SLD) + (size_t)d * M * 1024; e.ldc = 1024; e.coff = 0;
            run_gemm(smem, (const bf16_t*)(ws + OFF_ALO) + (size_t)d * M * 256, (const bf16_t*)(ws + OFF_WLORA) + (size_t)d * 1024 * 256, 1024, 256, e); }
        { EpiBf e; e.O = (bf16_t*)(ws + OFF_GBUF); e.ldc = 512; e.coff = 0;
          run_gemm(smem, (const bf16_t*)(ws + OFF_AG), (const bf16_t*)(ws + OFF_WGUP), 512, 256, e); }
        }
        PHASE_SYNC();
        for (int rep_ = 0; rep_ < (((PH_DUP >> 4) & 1) ? 2 : 1); ++rep_) if (((l + 1 < NLAYER) ? PH_MASK0 : PH_MASK) & (1 << 4)) {
        if (rep_ > 0) { PHASE_SYNC(); }
        if (rep_ > 0) { if (lbid() == 0 && ltid() == 0) ((unsigned*)(ws + OFF_CTL))[64 * (1 + l)] = 0u; PHASE_SYNC(); }
        mixers_phase(a, smem, l);
        }
        PHASE_SYNC();
        for (int rep_ = 0; rep_ < (((PH_DUP >> 5) & 1) ? 2 : 1); ++rep_) if (((l + 1 < NLAYER) ? PH_MASK0 : PH_MASK) & (1 << 5)) {
        if (rep_ > 0) { PHASE_SYNC(); }
        post_phase(a, smem, l);
        }
        PHASE_SYNC();
        for (int rep_ = 0; rep_ < (((PH_DUP >> 6) & 1) ? 2 : 1); ++rep_) if (((l + 1 < NLAYER) ? PH_MASK0 : PH_MASK) & (1 << 6)) {
        if (rep_ > 0) { PHASE_SYNC(); }
#pragma unroll 1
        for (int g = 0; g < 4; ++g) { EpiBf e; e.O = (bf16_t*)(ws + OFF_P); e.ldc = 8192; e.coff = g * 2048;
            const bf16_t* A = g == 0 ? (const bf16_t*)(ws + OFF_OA) : (g == 1 ? (const bf16_t*)(ws + OFF_OB) : (g == 2 ? (const bf16_t*)(ws + OFF_OC) : (const bf16_t*)(ws + OFF_OD)));
            const bf16_t* Bt = (const bf16_t*)(ws + OFF_WBR) + (g == 0 ? (size_t)0 : (size_t)2048 * 1024 + (size_t)(g - 1) * 2048 * 512);
            run_gemm(smem, A, Bt, 2048, g == 0 ? 1024 : 512, e); }
        }
        PHASE_SYNC();
        for (int rep_ = 0; rep_ < (((PH_DUP >> 7) & 1) ? 2 : 1); ++rep_) if (((l + 1 < NLAYER) ? PH_MASK0 : PH_MASK) & (1 << 7)) {
        if (rep_ > 0) { PHASE_SYNC(); }
        { EpiGate e; e.P = (const bf16_t*)(ws + OFF_P); e.Mg = (bf16_t*)(ws + OFF_MERGED);
          run_gemm(smem, hbuf, (const bf16_t*)(ws + OFF_WG), 8192, 2048, e); }
        }
        PHASE_SYNC();
        for (int rep_ = 0; rep_ < (((PH_DUP >> 8) & 1) ? 2 : 1); ++rep_) if (((l + 1 < NLAYER) ? PH_MASK0 : PH_MASK) & (1 << 8)) {
        if (rep_ > 0) { PHASE_SYNC(); }
        { EpiRes e; e.base = l == 0 ? a.in[0] : a.out; e.out = a.out;
          run_gemm(smem, (const bf16_t*)(ws + OFF_MERGED), (const bf16_t*)(ws + OFF_WO), 2048, 2048, e); }
        }
        PHASE_SYNC();
        for (int rep_ = 0; rep_ < (((PH_DUP >> 9) & 1) ? 2 : 1); ++rep_) if (((l + 1 < NLAYER) ? PH_MASK0 : PH_MASK) & (1 << 9)) {
        if (rep_ > 0) { PHASE_SYNC(); }
        rmsnorm_rows<true>(a.out, a.in[35] + l * 2048, hbuf, nullptr);
        }
        PHASE_SYNC();
        for (int rep_ = 0; rep_ < (((PH_DUP >> 10) & 1) ? 2 : 1); ++rep_) if (((l + 1 < NLAYER) ? PH_MASK0 : PH_MASK) & (1 << 10)) {
        if (rep_ > 0) { PHASE_SYNC(); }
        { EpiFfn e; e.act = (bf16_t*)(ws + OFF_ACT);
          run_gemm(smem, hbuf, (const bf16_t*)(ws + OFF_WFF), 11264, 2048, e); }
        }
        PHASE_SYNC();
        for (int rep_ = 0; rep_ < (((PH_DUP >> 11) & 1) ? 2 : 1); ++rep_) if (((l + 1 < NLAYER) ? PH_MASK0 : PH_MASK) & (1 << 11)) {
        if (rep_ > 0) { PHASE_SYNC(); }
        { EpiRes e; e.base = a.out; e.out = a.out;
          run_gemm(smem, (const bf16_t*)(ws + OFF_ACT), (const bf16_t*)(ws + OFF_WD), 2048, FFN, e); }
        }
        PHASE_SYNC();
}
__global__ void __launch_bounds__(NTHR) hybrid_encoder_fwd(Args a) {
    unsigned char* smem = g_smem;
    cg::grid_group grid = cg::this_grid();
    unsigned char* ws = launder_ws(a.ws);
    bf16_t* hbuf = (bf16_t*)(ws + OFF_H);
#if defined(WS_FILL)
    { u32x4* p = (u32x4*)(ws + 8192); const size_t n = (WS_END - 8192) / 16; const u32x4 v = {WS_FILL, WS_FILL, WS_FILL, WS_FILL};
      for (size_t i = (size_t)lbid() * NTHR + ltid(); i < n; i += (size_t)gridDim.x * NTHR) p[i] = v; }
    PHASE_SYNC();
#endif
    unsigned* xbar = (unsigned*)(launder_ws(a.ws) + OFF_XBAR);
    volatile XLAS unsigned* xst = (volatile XLAS unsigned*)(g_smem + LDS_BYTES - 64);
    if (ltid() == 0) { xst[0] = 0u; xst[1] = 0u; xst[2] = 0u; xst[3] = 0u; }
    if (lbid() == 0) { for (int i = ltid(); i < XCD_BAR_WORDS; i += NTHR) __hip_atomic_store(xbar + i, 0u, __ATOMIC_RELAXED, __HIP_MEMORY_SCOPE_AGENT); }
    asm volatile("s_waitcnt vmcnt(0) lgkmcnt(0)" ::: "memory"); __builtin_amdgcn_fence(__ATOMIC_RELEASE, "agent"); asm volatile("s_waitcnt vmcnt(0)" ::: "memory"); __syncthreads();
    grid.sync();
    __builtin_amdgcn_fence(__ATOMIC_ACQUIRE, "agent"); asm volatile("s_waitcnt vmcnt(0)" ::: "memory"); __syncthreads();
    const XcdBarrier xb = xcd_barrier_post(xbar, xst);
    run_layer<0>(a, smem, xb);
    if (NLAYER > 1) run_layer<1>(a, smem, xb);
#if defined(DBG_STOP)
    DBG_AT(0, OFF_H, M*2048, OFF_WIN, DINP*2048, OFF_WG, 8192*2048, OFF_WBR, 2048*2560)
    DBG_AT(1, OFF_BUFA, M*1536, OFF_BUFB, M*1536, OFF_BUFD, M*1536, OFF_BUFC, M*2048)
    DBG_AT(2, OFF_BUFA, M*1536, OFF_ALO, 3*M*256, OFF_ZT, 512*8*2048, OFF_VTA, 3*8*256*2048)
    DBG_AT(3, OFF_SLD, 2*M*512, OFF_SA, 2*M*512, OFF_GBUF, M*512, OFF_GBUF, M*512)
    DBG_AT(4, OFF_OA, M*1024, OFF_OD, M*512, OFF_OCDIR, 2*M*512, OFF_YT, 2*512*8*2048)
    DBG_AT(40, OFF_OA, M*1024, OFF_OA, M*1024, OFF_OD, M*512, OFF_OD, M*512)
    DBG_AT(41, OFF_OCDIR, 2*M*512, OFF_OCDIR, 2*M*512, OFF_OCDIR, 2*M*512, OFF_YT, 2*512*8*2048)
    DBG_AT(42, OFF_OA, M*1024, OFF_OA, M*1024, OFF_OA, M*1024, OFF_OA, M*1024)
    DBG_AT(43, OFF_OCDIR, 2*M*512, OFF_OCDIR, 2*M*512, OFF_OCDIR, 2*M*512, OFF_OCDIR, 2*M*512)
    DBG_AT(5, OFF_OB, M*512, OFF_OC, M*512, OFF_OB, M*512, OFF_OC, M*512)
    DBG_AT(6, OFF_P, M*8192, OFF_P, M*8192, OFF_P, M*8192, OFF_P, M*8192)
    DBG_AT(7, OFF_MERGED, M*2048, OFF_MERGED, M*2048, OFF_MERGED, M*2048, OFF_MERGED, M*2048)
    if (DBG_STOP == 11) { for (size_t i = (size_t)lbid() * NTHR + ltid(); i < (size_t)M * D; i += (size_t)gridDim.x * NTHR) { const float v = a.out[i]; a.out[i] = (fabsf(v) < 1e30f) ? v : 1e9f; } }
#else
    rmsnorm_rows<false>(a.out, a.in[39], nullptr, a.out);
#endif
}

extern "C" void kernel_launch(void* const* d_in, const int* in_sizes, int n_in, void* d_out, int out_size, void* d_ws, size_t ws_size, hipStream_t stream) {
    static int grid = 0;
    if (grid == 0) {
        if (n_in != 40 || out_size != M * D || ws_size < WS_END) { fprintf(stderr, "kernel_launch: unexpected shapes (n_in %d out %d ws %zu need %zu)\n", n_in, out_size, ws_size, (size_t)WS_END); grid = -1; return; }
        int dev = 0, cus = 0;
        hipGetDevice(&dev); hipDeviceGetAttribute(&cus, hipDeviceAttributeMultiprocessorCount, dev);
        if (hipFuncSetAttribute((const void*)hybrid_encoder_fwd, hipFuncAttributeMaxDynamicSharedMemorySize, LDS_BYTES) != hipSuccess) { fprintf(stderr, "kernel_launch: hipFuncSetAttribute failed\n"); grid = -1; return; }
        int per_cu = 0;
        hipOccupancyMaxActiveBlocksPerMultiprocessor(&per_cu, (const void*)hybrid_encoder_fwd, NTHR, LDS_BYTES);
        (void)hipGetLastError();
        grid = cus > 0 ? cus : 256;
    }
    if (grid < 0) return;
    Args a{};
    for (int i = 0; i < 40; ++i) a.in[i] = (const float*)d_in[i];
    a.out = (float*)d_out; a.ws = (unsigned char*)d_ws;
    void* args[] = {&a};
    hipError_t e = hipLaunchCooperativeKernel((const void*)hybrid_encoder_fwd, dim3(grid), dim3(NTHR), args, LDS_BYTES, stream);
    if (e != hipSuccess) fprintf(stderr, "cooperative launch failed: %s (grid %d)\n", hipGetErrorString(e), grid);
}
```

```cpp
#ifndef PG8_V2
#define PG8_V2 1
#endif
#ifndef PG8_SP2
#define PG8_SP2 true
#endif
#include <hip/hip_runtime.h>
#include <hip/hip_cooperative_groups.h>
#include <cstdio>
#include <cstdint>
namespace cg = cooperative_groups;
namespace pg8 {
#define PG8_LAS __attribute__((address_space(3)))
typedef unsigned short bf16_t;
typedef short bf16x8 __attribute__((ext_vector_type(8)));
typedef float f32x4 __attribute__((ext_vector_type(4)));
typedef unsigned u32x4 __attribute__((ext_vector_type(4)));
constexpr int BM = 256, BK = 64, HALF = 128, HTB = HALF * BK * 2  , STAGE_BYTES = 8 * HTB, NXCD = 8, WGM = 4;

__host__ __device__ __forceinline__ int lds_byte(int r, int c) { const int st = (r >> 4) * 2 + (c >> 5), rr = r & 15, cc = c & 31, ob = rr * 64 + cc * 2; return st * 1024 + (ob ^ (((ob >> 9) & 1) << 5)); }
__host__ __device__ __forceinline__ void stage_rc(int b, int& R, int& C) { const int st = b / 1024, sb = b % 1024, swz = sb ^ (((sb >> 9) & 1) << 5); R = (st >> 1) * 16 + swz / 64; C = (st & 1) * 32 + (swz % 64) / 2; }
__host__ __device__ __forceinline__ int perm32(int rho) { const int n = rho >> 4, i = rho & 15; return 8 * (i >> 2) + 4 * n + (i & 3); }

struct Unit { int pm, pn; };
struct Gemm { const bf16_t* A; const bf16_t* Bt; int M, N, K; };

struct StaticOrder {
    int nM, nN, nwg, G, c;
    __host__ __device__ void init(int M, int N, int G_, int c_) { nM = M / BM; nN = N / BM; nwg = nM * nN; G = G_; c = c_; }
    __host__ __device__ bool next(int i, Unit& u) const {
        const long L = (long)i * G + c; if (L >= nwg) return false;
        int wgid = (int)L; { const int q = nwg / NXCD, r = nwg % NXCD, xcd = wgid % NXCD, off = wgid / NXCD; wgid = (xcd < r ? xcd * (q + 1) : r * (q + 1) + (xcd - r) * q) + off; }
        const int nig = WGM * nN, gid = wgid / nig, fm = gid * WGM, gsz = (nM - fm) < WGM ? (nM - fm) : WGM;
        u.pm = fm + ((wgid % nig) % gsz); u.pn = (wgid % nig) / gsz; return true;
    }
    __device__ __forceinline__ void a_ready(const Unit&) const {}
    __device__ __forceinline__ void done(const Unit&) const {}
};
__device__ __forceinline__ unsigned cvt_pk_bf16(float lo, float hi) { unsigned r; asm volatile("v_cvt_pk_bf16_f32 %0, %1, %2" : "=v"(r) : "v"(lo), "v"(hi)); return r; }
typedef float f32x2 __attribute__((ext_vector_type(2)));
template <class Epi, class Sched, bool ALIGN_EPI = false, bool SP2 = false>
__device__ __forceinline__ void gemm_phase(PG8_LAS unsigned char* lds, const Gemm g, const Sched& S, const Epi& E) {
    int tid = threadIdx.x; asm volatile("" : "+v"(tid));
    const int wid = __builtin_amdgcn_readfirstlane(tid >> 6), lane = tid & 63, wr = wid >> 2, wc = wid & 3, fr = lane & 15, fq = lane >> 4;
    const int K = g.K, nt = K / BK;
    unsigned voffA[2], voffB[2];
#pragma unroll
    for (int i = 0; i < 2; ++i) { int R, C; stage_rc(tid * 16 + i * 8192, R, C); const int Rb = Epi::PERM ? ((R & ~31) + perm32(R & 31)) : R;
        voffA[i] = (unsigned)(R * K + C) * 2u; voffB[i] = (unsigned)(Rb * K + C) * 2u; }
    const size_t kstep = (size_t)(BK * 2);
    const size_t hstep = (size_t)HALF * K * 2;
    const size_t tstep = 2 * hstep;
    const unsigned ldsw = (unsigned)wid * 1024u;
    const int aoff = lds_byte(wr * 64 + fr, fq * 8), boff = lds_byte(wc * 32 + fr, fq * 8);
#define PG8_SA(b, h) (((b) * 2 + (h)) * HTB)
#define PG8_SB(b, h) ((4 + (b) * 2 + (h)) * HTB)
#define PG8_STAGE(bufoff, gbase, voff) do { _Pragma("unroll") for (int _i = 0; _i < 2; ++_i) \
        __builtin_amdgcn_global_load_lds((const unsigned*)((const char*)(gbase) + (voff)[_i]), (PG8_LAS unsigned*)(lds + (bufoff) + ldsw + _i * 8192), 16, 0, 0); } while (0)
#define PG8_LDA(dst, b, h) do { _Pragma("unroll") for (int m = 0; m < 4; ++m) _Pragma("unroll") for (int k = 0; k < 2; ++k) dst[m][k] = *(const PG8_LAS bf16x8*)(lds + PG8_SA(b, h) + aoff + m * 2048 + k * 1024); } while (0)
#define PG8_LDB(dst, b, h) do { _Pragma("unroll") for (int n = 0; n < 2; ++n) _Pragma("unroll") for (int k = 0; k < 2; ++k) dst[n][k] = *(const PG8_LAS bf16x8*)(lds + PG8_SB(b, h) + boff + n * 2048 + k * 1024); } while (0)
#define PG8_MMA(ai, bj, At, Bt) do { __builtin_amdgcn_s_setprio(1); _Pragma("unroll") for (int m = 0; m < 4; ++m) _Pragma("unroll") for (int n = 0; n < 2; ++n) _Pragma("unroll") for (int k = 0; k < 2; ++k) \
        acc[ai][bj][m][n] = __builtin_amdgcn_mfma_f32_16x16x32_bf16(Bt[n][k], At[m][k], acc[ai][bj][m][n], 0, 0, 0); __builtin_amdgcn_s_setprio(0); } while (0)
#define PG8_WAIT_V(n) asm volatile("s_waitcnt vmcnt(" #n ")" ::: "memory")
#define PG8_WAIT_L(n) asm volatile("s_waitcnt lgkmcnt(" #n ")" ::: "memory")
#define PG8_BAR __builtin_amdgcn_s_barrier()
#define PG8_SCHED __builtin_amdgcn_sched_barrier(0)
    Unit cur, nxt; int ui = 0;
    if (!S.next(0, cur)) return;
    f32x4 acc[2][2][4][2];
#pragma unroll
    for (int a = 0; a < 2; ++a)
#pragma unroll
        for (int b = 0; b < 2; ++b)
#pragma unroll
            for (int m = 0; m < 4; ++m)
#pragma unroll
                for (int n = 0; n < 2; ++n) acc[a][b][m][n] = (f32x4){0.f, 0.f, 0.f, 0.f};
    bf16x8 At[4][2], B0[2][2], B1[2][2];
    const char* cA = (const char*)g.A + (size_t)cur.pm * tstep; const char* cB = (const char*)g.Bt + (size_t)cur.pn * tstep;
    S.a_ready(cur);
    if constexpr (SP2) {
        PG8_STAGE(PG8_SB(0, 0), cB, voffB); PG8_STAGE(PG8_SB(0, 1), cB + hstep, voffB); PG8_STAGE(PG8_SA(0, 0), cA, voffA); PG8_STAGE(PG8_SA(0, 1), cA + hstep, voffA);
        if (wr == 1) PG8_BAR;
        PG8_WAIT_V(2); PG8_BAR;
        PG8_STAGE(PG8_SB(1, 0), cB + kstep, voffB); PG8_STAGE(PG8_SA(1, 0), cA + kstep, voffA); PG8_STAGE(PG8_SB(1, 1), cB + hstep + kstep, voffB);
        PG8_WAIT_V(6); PG8_BAR;
    } else {
        PG8_STAGE(PG8_SB(0, 0), cB, voffB); PG8_STAGE(PG8_SA(0, 0), cA, voffA); PG8_STAGE(PG8_SB(0, 1), cB + hstep, voffB); PG8_STAGE(PG8_SA(0, 1), cA + hstep, voffA);
        if (wr == 1) PG8_BAR;
        PG8_WAIT_V(4); PG8_BAR;
        PG8_STAGE(PG8_SB(1, 0), cB + kstep, voffB); PG8_STAGE(PG8_SA(1, 0), cA + kstep, voffA); PG8_STAGE(PG8_SB(1, 1), cB + hstep + kstep, voffB);
        PG8_WAIT_V(6); PG8_BAR;
    }
    for (;;) {
        const bool has_next = S.next(ui + 1, nxt);
        const char* nA = has_next ? (const char*)g.A + (size_t)nxt.pm * tstep : cA; const char* nB = has_next ? (const char*)g.Bt + (size_t)nxt.pn * tstep : cB;
        for (int t = 0; t < nt; t += 2) {
            const bool last = (t == nt - 2);
            const char* a1 = cA + (size_t)(t + 1) * kstep;
            const char* a2 = last ? nA : cA + (size_t)(t + 2) * kstep; const char* b2 = last ? nB : cB + (size_t)(t + 2) * kstep;
            const char* a3 = a2 + kstep; const char* b3 = b2 + kstep;
            if (last && has_next) S.a_ready(nxt);
            if constexpr (SP2) {
            PG8_LDB(B0, 0, 0); PG8_LDB(B1, 0, 1); PG8_SCHED; PG8_LDA(At, 0, 0); PG8_STAGE(PG8_SA(1, 1), a1 + hstep, voffA);
            PG8_WAIT_V(8); PG8_WAIT_L(0); PG8_BAR; PG8_MMA(0, 0, At, B0); PG8_MMA(0, 1, At, B1); PG8_BAR; PG8_SCHED;
            PG8_LDA(At, 0, 1); PG8_STAGE(PG8_SB(0, 0), b2, voffB); PG8_STAGE(PG8_SB(0, 1), b2 + hstep, voffB); PG8_STAGE(PG8_SA(0, 0), a2, voffA);
            PG8_WAIT_V(8); PG8_WAIT_L(0); PG8_BAR; PG8_MMA(1, 0, At, B0); PG8_MMA(1, 1, At, B1); PG8_BAR; PG8_SCHED;
            PG8_LDB(B0, 1, 0); PG8_LDB(B1, 1, 1); PG8_SCHED; PG8_LDA(At, 1, 0); PG8_STAGE(PG8_SA(0, 1), a2 + hstep, voffA);
            PG8_WAIT_V(8); PG8_WAIT_L(0); PG8_BAR; PG8_MMA(0, 0, At, B0); PG8_MMA(0, 1, At, B1); PG8_BAR; PG8_SCHED;
            PG8_LDA(At, 1, 1); PG8_STAGE(PG8_SB(1, 0), b3, voffB); PG8_STAGE(PG8_SB(1, 1), b3 + hstep, voffB); PG8_STAGE(PG8_SA(1, 0), a3, voffA);
            PG8_WAIT_V(8); PG8_WAIT_L(0); PG8_BAR; PG8_MMA(1, 0, At, B0); PG8_MMA(1, 1, At, B1); PG8_BAR; PG8_SCHED;
            } else {
            PG8_LDB(B0, 0, 0); PG8_SCHED; PG8_LDA(At, 0, 0); PG8_STAGE(PG8_SA(1, 1), a1 + hstep, voffA);
            PG8_WAIT_L(8); PG8_BAR; PG8_WAIT_L(0); PG8_MMA(0, 0, At, B0); PG8_BAR; PG8_SCHED;
            PG8_LDB(B1, 0, 1); PG8_STAGE(PG8_SB(0, 0), b2, voffB);
            PG8_BAR; PG8_WAIT_L(0); PG8_MMA(0, 1, At, B1); PG8_BAR;
            PG8_LDA(At, 0, 1); PG8_STAGE(PG8_SA(0, 0), a2, voffA);
            PG8_BAR; PG8_WAIT_L(0); PG8_MMA(1, 0, At, B0); PG8_BAR; PG8_SCHED;
            PG8_STAGE(PG8_SB(0, 1), b2 + hstep, voffB);
            PG8_WAIT_V(6); PG8_BAR; PG8_MMA(1, 1, At, B1); PG8_BAR;
            PG8_LDB(B0, 1, 0); PG8_SCHED; PG8_LDA(At, 1, 0); PG8_STAGE(PG8_SA(0, 1), a2 + hstep, voffA);
            PG8_WAIT_L(8); PG8_BAR; PG8_WAIT_L(0); PG8_MMA(0, 0, At, B0); PG8_BAR; PG8_SCHED;
            PG8_LDB(B1, 1, 1); PG8_STAGE(PG8_SB(1, 0), b3, voffB);
            PG8_BAR; PG8_WAIT_L(0); PG8_MMA(0, 1, At, B1); PG8_BAR;
            PG8_LDA(At, 1, 1); PG8_STAGE(PG8_SA(1, 0), a3, voffA);
            PG8_BAR; PG8_WAIT_L(0); PG8_MMA(1, 0, At, B0); PG8_BAR; PG8_SCHED;
            PG8_STAGE(PG8_SB(1, 1), b3 + hstep, voffB);
            PG8_WAIT_V(6); PG8_BAR; PG8_MMA(1, 1, At, B1); PG8_BAR;
            }
        }
        if constexpr (ALIGN_EPI) { if (wr == 0) PG8_BAR; }
        if constexpr (!Epi::AFTER_DRAIN) { E(acc, cur, wr, wc, fr, fq); S.done(cur); }
        if (!has_next) break;
#pragma unroll
        for (int a = 0; a < 2; ++a)
#pragma unroll
            for (int b = 0; b < 2; ++b)
#pragma unroll
                for (int m = 0; m < 4; ++m)
#pragma unroll
                    for (int n = 0; n < 2; ++n) acc[a][b][m][n] = (f32x4){0.f, 0.f, 0.f, 0.f};
        cur = nxt; cA = nA; cB = nB; ++ui;
        if constexpr (ALIGN_EPI) { if (wr == 1) PG8_BAR; }
    }
    PG8_WAIT_V(0);
    if constexpr (!ALIGN_EPI) { if (wr == 0) PG8_BAR; }
    PG8_BAR;
    if constexpr (Epi::AFTER_DRAIN) { E.fused(acc, cur, wr, wc, fr, fq, lds, wid, lane); S.done(cur); }
#undef PG8_SA
#undef PG8_SB
#undef PG8_STAGE
#undef PG8_LDA
#undef PG8_LDB
#undef PG8_MMA
#undef PG8_WAIT_V
#undef PG8_WAIT_L
#undef PG8_BAR
#undef PG8_SCHED
}
}
#define XB_TMO      128
#define XB_XCNT(j)  (256  + 64 * (j))
#define XB_XSUB(j)  (1280 + 64 * (j))
#define XB_XGEN(j)  (2304 + 64 * (j))
#define XB_TOP      3328
#define XB_TOPGEN   3392
#define XCD_BAR_WORDS 3456
#define XB_SPIN_CAP (1u << 18)
#define XLAS __attribute__((address_space(3)))

__device__ __forceinline__ unsigned xb_ld(unsigned* p)              { return __hip_atomic_load(p, __ATOMIC_RELAXED, __HIP_MEMORY_SCOPE_AGENT); }
__device__ __forceinline__ unsigned xb_add(unsigned* p, unsigned v) { return __hip_atomic_fetch_add(p, v, __ATOMIC_RELAXED, __HIP_MEMORY_SCOPE_AGENT); }
__device__ __forceinline__ unsigned xb_xcc_id() { return (unsigned)__builtin_amdgcn_s_getreg((3 << 11) | 20) & 0xFu; }
#define XB_SPIN(cond, bar) do { unsigned _sp = 0; while (cond) { __builtin_amdgcn_s_sleep(1); \
    if ((++_sp & 255u) == 0u) { if (xb_ld(&(bar)[XB_TMO])) break; if (_sp > XB_SPIN_CAP) { atomicAdd(&(bar)[XB_TMO], 1u); break; } } } } while (0)

struct XcdBarrier {
    unsigned* bar; unsigned x;
    volatile XLAS unsigned* st;
};

__device__ __forceinline__ XcdBarrier xcd_barrier_post(unsigned* bar, volatile XLAS unsigned* st) {
    XcdBarrier b; b.bar = bar; b.x = xb_xcc_id(); b.st = st;
    if (threadIdx.x == 0) (void)xb_add(&bar[XB_XCNT(b.x)], 1u);
    return b;
}
__device__ __forceinline__ void xcd_barrier_complete(unsigned* bar, unsigned x, unsigned& nloc, unsigned& nx) {
    const unsigned G = gridDim.x * gridDim.y * gridDim.z;
    unsigned sum, cnt, mine, sp = 0u;
    for (;;) {
        sum = 0u; cnt = 0u; mine = 0u;
#pragma unroll
        for (unsigned j = 0; j < 16; ++j) { const unsigned c = xb_ld(&bar[XB_XCNT(j)]); sum += c; cnt += (c > 0u) ? 1u : 0u; mine = (j == x) ? c : mine; }
        if (sum == G) break;
        __builtin_amdgcn_s_sleep(1);
        if ((++sp & 255u) == 0u) { if (xb_ld(&bar[XB_TMO])) break; if (sp > XB_SPIN_CAP) { atomicAdd(&bar[XB_TMO], 1u); break; } }
    }
    nloc = mine > 0u ? mine : 1u; nx = cnt > 0u ? cnt : 1u;
}

__device__ __forceinline__ void xcd_barrier(const XcdBarrier& b) {
    asm volatile("s_waitcnt vmcnt(0)" ::: "memory");
    __syncthreads();
    if (threadIdx.x == 0) {
        unsigned* bar = b.bar;
        __builtin_amdgcn_s_waitcnt(0);
        unsigned nloc = b.st[0], nx = b.st[1];
        if (nloc == 0u) { xcd_barrier_complete(bar, b.x, nloc, nx); b.st[0] = nloc; b.st[1] = nx; }
        const unsigned old = xb_add(&bar[XB_XSUB(b.x)], 1u);
        const unsigned gen = old / nloc;
        if (old + 1u == (gen + 1u) * nloc) {
            __builtin_amdgcn_fence(__ATOMIC_RELEASE, "agent");
            asm volatile("s_waitcnt vmcnt(0)" ::: "memory");
            const unsigned og = xb_add(&bar[XB_TOP], 1u);
            const unsigned tg = og / nx;
            if (og + 1u == (tg + 1u) * nx) xb_add(&bar[XB_TOPGEN], 1u);
            else XB_SPIN(xb_ld(&bar[XB_TOPGEN]) == tg, bar);
            __builtin_amdgcn_fence(__ATOMIC_ACQUIRE, "agent");
            xb_add(&bar[XB_XGEN(b.x)], 1u);
            asm volatile("s_waitcnt vmcnt(0)" ::: "memory");
        } else {
            XB_SPIN(xb_ld(&bar[XB_XGEN(b.x)]) == gen, bar);
            __builtin_amdgcn_fence(__ATOMIC_ACQUIRE, "agent");
            asm volatile("s_waitcnt vmcnt(0)" ::: "memory");
        }
    }
    __syncthreads();
}

using pg8::bf16_t; using pg8::bf16x8; using pg8::f32x4; using pg8::u32x4;
typedef float f32x16 __attribute__((ext_vector_type(16)));
typedef unsigned u32x2 __attribute__((ext_vector_type(2)));
#define LAS __attribute__((address_space(3)))

constexpr int D = 2048, NBATCH = 8, T = 2048, M = NBATCH * T, FFN = 5632, DINP = 6656;
constexpr int NTHR = 512;
constexpr int LDS_BYTES = 143360;

constexpr size_t al256(size_t x) { return (x + 255) & ~(size_t)255; }
constexpr size_t OFF_CTL = 0;
constexpr size_t OFF_LAM = 4096;
constexpr size_t OFF_HID3 = 8192;
constexpr size_t OFF_WIN = OFF_HID3 + (size_t)2 * 2048 * 64 * 4;
constexpr size_t OFF_WG = OFF_WIN + (size_t)DINP * 2048 * 2;
constexpr size_t OFF_WBR = OFF_WG + (size_t)8192 * 2048 * 2;
constexpr size_t OFF_WO = OFF_WBR + (size_t)2048 * 2560 * 2;
constexpr size_t OFF_WLORA = OFF_WO + (size_t)2048 * 2048 * 2;
constexpr size_t OFF_WGUP = OFF_WLORA + (size_t)2 * 1024 * 256 * 2;
constexpr size_t OFF_H = OFF_WGUP + (size_t)512 * 256 * 2;
constexpr size_t OFF_OA = OFF_H + (size_t)M * 2048 * 2;
constexpr size_t OFF_OB = OFF_OA + (size_t)M * 1024 * 2;
constexpr size_t OFF_OC = OFF_OB + (size_t)M * 512 * 2;
constexpr size_t OFF_OD = OFF_OC + (size_t)M * 512 * 2;
constexpr size_t OFF_MERGED = OFF_OA;
constexpr size_t OFF_BIG = OFF_OD + (size_t)M * 512 * 2;
constexpr size_t OFF_BUFA = OFF_BIG;
constexpr size_t OFF_BUFB = OFF_BUFA + (size_t)M * 1536 * 2;
constexpr size_t OFF_BUFD = OFF_BUFB + (size_t)M * 1536 * 2;
constexpr size_t OFF_BUFC = OFF_BUFD + (size_t)M * 1536 * 2;
constexpr size_t OFF_SLD = OFF_BUFC + (size_t)M * 2048 * 2;
constexpr size_t OFF_SA = OFF_SLD + (size_t)2 * M * 512 * 2;
constexpr size_t OFF_ZT = OFF_SA + (size_t)2 * M * 512 * 2;
constexpr size_t OFF_VTA = OFF_ZT + (size_t)512 * 8 * 2048 * 2;
constexpr size_t OFF_VTD = OFF_VTA + (size_t)8 * 256 * 2048 * 2;
constexpr size_t OFF_GBUF = OFF_VTD + (size_t)8 * 512 * 2048 * 2;
constexpr size_t OFF_OCDIR = OFF_GBUF + (size_t)M * 512 * 2;
constexpr size_t OFF_YT = OFF_OCDIR + (size_t)2 * M * 512 * 2;
constexpr size_t OFF_ALO = OFF_YT;
constexpr size_t OFF_AG = OFF_ALO + (size_t)2 * M * 256 * 2;
constexpr size_t OFF_BIGEND = OFF_YT + (size_t)512 * 8 * 2048 * 4;
constexpr size_t OFF_P = OFF_BIG;
constexpr size_t OFF_ACT = OFF_BIG;
constexpr size_t OFF_XBAR = OFF_BIGEND;
constexpr size_t OFF_WFF = OFF_BIGEND + 16384;
constexpr size_t OFF_WD = OFF_WFF + (size_t)11264 * 2048 * 2;
constexpr size_t WS_END = OFF_WD + (size_t)2048 * FFN * 2;
static_assert(OFF_P + (size_t)M * 8192 * 2 <= OFF_BIGEND, "P alias");
static_assert(OFF_AG + (size_t)M * 256 * 2 <= OFF_BIGEND, "Ag alias");
static_assert(WS_END <= 732154368ull, "workspace");

struct Args { const float* in[40]; float* out; unsigned char* ws; };
extern __shared__ __attribute__((aligned(16))) unsigned char g_smem[];

typedef __attribute__((address_space(1))) unsigned char gas_uchar;
__device__ __forceinline__ unsigned char* launder_ws(unsigned char* p) { gas_uchar* g = (gas_uchar*)p; asm volatile("" : "+s"(g)); return (unsigned char*)g; }
__device__ __forceinline__ float bf2f(bf16_t v) { return __uint_as_float(((unsigned)v) << 16); }
__device__ __forceinline__ float bflo(unsigned v) { return __uint_as_float(v << 16); }
__device__ __forceinline__ float bfhi(unsigned v) { return __uint_as_float(v & 0xffff0000u); }
typedef float f32x2c_ __attribute__((ext_vector_type(2)));
typedef __bf16 bf16x2c_ __attribute__((ext_vector_type(2)));
__device__ __forceinline__ unsigned pk2(float lo, float hi) { const f32x2c_ v = {lo, hi}; const bf16x2c_ b = __builtin_convertvector(v, bf16x2c_); return __builtin_bit_cast(unsigned, b); }
__device__ __forceinline__ bf16_t f2bf(float f) { return (bf16_t)(pk2(f, 0.f) & 0xffffu); }
__device__ __forceinline__ int ltid() { int t = threadIdx.x; asm volatile("" : "+v"(t)); return t; }
__device__ __forceinline__ int lbid() { int b = blockIdx.x; asm volatile("" : "+s"(b)); return b; }
__device__ __forceinline__ float shx(float v, int mask, int lane) { return __int_as_float(__builtin_amdgcn_ds_bpermute((lane ^ mask) << 2, __float_as_int(v))); }
template <int CTRL> __device__ __forceinline__ float dppf(float v) { return __int_as_float(__builtin_amdgcn_update_dpp(0, __float_as_int(v), CTRL, 0xF, 0xF, true)); }
__device__ __forceinline__ float wave_sum(float v, int lane) {
    v += dppf<0xB1>(v); v += dppf<0x4E>(v); v += dppf<0x141>(v); v += dppf<0x140>(v);
    v += shx(v, 16, lane);
    return v + shx(v, 32, lane);
}
__device__ __forceinline__ float half_sum(float v, int lane) {
    v += dppf<0xB1>(v); v += dppf<0x4E>(v); v += dppf<0x141>(v); v += dppf<0x140>(v);
    return v + shx(v, 16, lane);
}
__device__ __forceinline__ float sum8(float v) {
    v += dppf<0xB1>(v); v += dppf<0x4E>(v); v += dppf<0x141>(v); return v;
}
__device__ __forceinline__ float sigmoidf_(float x) { return __builtin_amdgcn_rcpf(1.f + __expf(-x)); }

struct EpiIn {
    static constexpr bool PERM = true, AFTER_DRAIN = false;
    bf16_t *bA, *bB, *bD, *bC;
    __device__ __forceinline__ void operator()(const f32x4 (&acc)[2][2][4][2], const pg8::Unit& u, int wr, int wc, int fr, int fq) const {
        bf16_t* base; int ldc, ct;
        if (u.pn < 6) { base = bA; ldc = 1536; ct = u.pn; } else if (u.pn < 12) { base = bB; ldc = 1536; ct = u.pn - 6; }
        else if (u.pn < 18) { base = bD; ldc = 1536; ct = u.pn - 12; } else { base = bC; ldc = 2048; ct = u.pn - 18; }
        const int row0 = u.pm * 256 + wr * 64 + fr, col0 = ct * 256 + wc * 32 + 8 * fq;
#pragma unroll
        for (int ai = 0; ai < 2; ++ai)
#pragma unroll
            for (int m = 0; m < 4; ++m) { bf16_t* rowp = base + (size_t)(row0 + ai * 128 + m * 16) * ldc + col0;
#pragma unroll
                for (int bj = 0; bj < 2; ++bj) { const f32x4 v0 = acc[ai][bj][m][0], v1 = acc[ai][bj][m][1];
                    u32x4 w; w.x = pk2(v0[0], v0[1]); w.y = pk2(v0[2], v0[3]); w.z = pk2(v1[0], v1[1]); w.w = pk2(v1[2], v1[3]);
                    *(u32x4*)(rowp + bj * 128) = w; } }
    }
};
struct EpiBf {
    static constexpr bool PERM = true, AFTER_DRAIN = false;
    bf16_t* O; int ldc; int coff;
    __device__ __forceinline__ void operator()(const f32x4 (&acc)[2][2][4][2], const pg8::Unit& u, int wr, int wc, int fr, int fq) const {
        const int row0 = u.pm * 256 + wr * 64 + fr, col0 = coff + u.pn * 256 + wc * 32 + 8 * fq;
#pragma unroll
        for (int ai = 0; ai < 2; ++ai)
#pragma unroll
            for (int m = 0; m < 4; ++m) { bf16_t* rowp = O + (size_t)(row0 + ai * 128 + m * 16) * ldc + col0;
#pragma unroll
                for (int bj = 0; bj < 2; ++bj) { const f32x4 v0 = acc[ai][bj][m][0], v1 = acc[ai][bj][m][1];
                    u32x4 w; w.x = pk2(v0[0], v0[1]); w.y = pk2(v0[2], v0[3]); w.z = pk2(v1[0], v1[1]); w.w = pk2(v1[2], v1[3]);
                    *(u32x4*)(rowp + bj * 128) = w; } }
    }
};
struct EpiGate {
    static constexpr bool PERM = false, AFTER_DRAIN = false;
    const bf16_t* P; bf16_t* Mg;
    __device__ __forceinline__ void operator()(const f32x4 (&acc)[2][2][4][2], const pg8::Unit& u, int wr, int wc, int fr, int fq) const {
        const int row0 = u.pm * 256 + wr * 64 + fr, col0 = u.pn * 64 + wc * 16 + 4 * fq;
#pragma unroll
        for (int ai = 0; ai < 2; ++ai)
#pragma unroll
            for (int m = 0; m < 4; ++m) { const size_t row = (size_t)(row0 + ai * 128 + m * 16);
                f32x4 o = {0.f, 0.f, 0.f, 0.f};
#pragma unroll
                for (int g = 0; g < 4; ++g) { const u32x2 pv = *(const u32x2*)(P + row * 8192 + g * 2048 + col0); const f32x4 gv = acc[ai][g >> 1][m][g & 1];
                    o[0] += sigmoidf_(gv[0]) * bflo(pv.x); o[1] += sigmoidf_(gv[1]) * bfhi(pv.x); o[2] += sigmoidf_(gv[2]) * bflo(pv.y); o[3] += sigmoidf_(gv[3]) * bfhi(pv.y); }
                u32x2 w; w.x = pk2(o[0], o[1]); w.y = pk2(o[2], o[3]);
                *(u32x2*)(Mg + row * 2048 + col0) = w; }
    }
};
struct EpiRes {
    static constexpr bool PERM = false, AFTER_DRAIN = false;
    const float* base; float* out;
    __device__ __forceinline__ void operator()(const f32x4 (&acc)[2][2][4][2], const pg8::Unit& u, int wr, int wc, int fr, int fq) const {
        const int row0 = u.pm * 256 + wr * 64 + fr, col0 = u.pn * 256 + wc * 32 + 4 * fq;
#pragma unroll
        for (int ai = 0; ai < 2; ++ai)
#pragma unroll
            for (int m = 0; m < 4; ++m) { const size_t off = (size_t)(row0 + ai * 128 + m * 16) * 2048 + col0;
#pragma unroll
                for (int bj = 0; bj < 2; ++bj)
#pragma unroll
                    for (int n = 0; n < 2; ++n) { const f32x4 bs = *(const f32x4*)(base + off + bj * 128 + n * 16); *(f32x4*)(out + off + bj * 128 + n * 16) = bs + acc[ai][bj][m][n]; } }
    }
};
struct EpiFfn {
    static constexpr bool PERM = true, AFTER_DRAIN = false;
    bf16_t* act;
    __device__ __forceinline__ void operator()(const f32x4 (&acc)[2][2][4][2], const pg8::Unit& u, int wr, int wc, int fr, int fq) const {
        const int row0 = u.pm * 256 + wr * 64 + fr, col0 = u.pn * 128 + wc * 32 + 8 * fq;
#pragma unroll
        for (int ai = 0; ai < 2; ++ai)
#pragma unroll
            for (int m = 0; m < 4; ++m) { bf16_t* rowp = act + (size_t)(row0 + ai * 128 + m * 16) * FFN + col0;
                const f32x4 g0 = acc[ai][0][m][0], g1 = acc[ai][0][m][1], u0 = acc[ai][1][m][0], u1 = acc[ai][1][m][1]; f32x4 o0, o1;
#pragma unroll
                for (int j = 0; j < 4; ++j) { o0[j] = g0[j] * sigmoidf_(g0[j]) * u0[j]; o1[j] = g1[j] * sigmoidf_(g1[j]) * u1[j]; }
                u32x4 w; w.x = pk2(o0[0], o0[1]); w.y = pk2(o0[2], o0[3]); w.z = pk2(o1[0], o1[1]); w.w = pk2(o1[2], o1[3]);
                *(u32x4*)rowp = w; }
    }
};
template <class Epi> __device__ __forceinline__ void run_gemm(unsigned char* smem, const bf16_t* A, const bf16_t* Bt, int N, int K, const Epi& E) {
    pg8::Gemm g; g.A = A; g.Bt = Bt; g.M = M; g.N = N; g.K = K;
    pg8::StaticOrder S; S.init(M, N, (int)gridDim.x, lbid());
    __syncthreads();
#if PG8_V2
#ifndef PG8_ALIGN
#define PG8_ALIGN true
#endif
    pg8::gemm_phase<Epi, pg8::StaticOrder, PG8_ALIGN, PG8_SP2>((PG8_LAS unsigned char*)g_smem, g, S, E);
#else
    pg8::gemm_phase<Epi, pg8::StaticOrder, false>((PG8_LAS unsigned char*)g_smem, g, S, E, nullptr);
#endif
    __syncthreads();
}
__device__ __forceinline__ const float* wsrc(const Args& a, int mat, int l, int np, bool& valid, size_t& ld) {
    valid = true;
    if (mat == 0) { const int sc = np < 3072 ? np : (np < 4608 ? np + 1984 : (np < 6592 ? np - 1536 : -1)); valid = sc >= 0; ld = 6592; return a.in[2] + (size_t)l * 2048 * 6592 + (sc >= 0 ? sc : 0); }
    if (mat == 1) { const int pn = np >> 8, c = np & 255, g = 2 * (c >> 7) + ((c >> 4) & 1), col = 64 * pn + 16 * ((c >> 5) & 3) + (c & 15); ld = 2048; return a.in[32] + ((size_t)(l * 4 + g) * 2048) * 2048 + col; }
    if (mat <= 5) { const int g = mat - 2, koff = g == 0 ? 0 : 1024 + (g - 1) * 512; ld = 2048; return a.in[33] + (size_t)l * 2560 * 2048 + (size_t)koff * 2048 + np; }
    if (mat == 6) { ld = 2048; return a.in[34] + (size_t)l * 2048 * 2048 + np; }
    if (mat == 7) { const int pn = np >> 8, c = np & 255, ty = c >> 7, col = 128 * pn + (c & 127); ld = FFN; return (ty ? a.in[37] : a.in[36]) + (size_t)l * 2048 * FFN + col; }
    ld = 2048; return a.in[38] + (size_t)l * FFN * 2048 + np;
}
struct WItem { int mat, kt, ng, K; bf16_t* dst; };
__device__ __forceinline__ void witem_load(const Args& a, int l, const WItem& w, float (&rg)[32]) {
    const int tid = ltid(), kr = tid >> 6, n4 = tid & 63, k0 = w.kt * 64;
    bool vd; size_t ld = 0; const float* sp = wsrc(a, w.mat, l, w.ng * 256 + 4 * n4, vd, ld);
#pragma unroll
    for (int i = 0; i < 8; ++i) { f32x4 v = {0.f, 0.f, 0.f, 0.f}; if (vd) v = *(const f32x4*)(sp + (size_t)(k0 + kr + 8 * i) * ld);
        rg[4 * i] = v[0]; rg[4 * i + 1] = v[1]; rg[4 * i + 2] = v[2]; rg[4 * i + 3] = v[3]; }
}
__device__ __forceinline__ void witem_tolds(float* tile, const float (&rg)[32]) {
    const int tid = ltid(), kr = tid >> 6, n4 = tid & 63, q = n4 >> 4, nc = (n4 & 15) * 4;
#pragma unroll
    for (int i = 0; i < 8; ++i)
#pragma unroll
        for (int e = 0; e < 4; ++e) tile[q * 4160 + (kr + 8 * i) * 65 + nc + e] = rg[4 * i + e];
}
__device__ __forceinline__ void witem_store(const WItem& w, const float* tile) {
    const int tid = ltid(), nr = tid >> 3, kc = tid & 7, k0 = w.kt * 64;
#pragma unroll
    for (int q = 0; q < 4; ++q) { const float* tp = tile + q * 4160 + (kc * 8) * 65 + nr;
        u32x4 o; o.x = pk2(tp[0], tp[65]); o.y = pk2(tp[130], tp[195]); o.z = pk2(tp[260], tp[325]); o.w = pk2(tp[390], tp[455]);
        *(u32x4*)(w.dst + (size_t)((w.ng * 4 + q) * 64 + nr) * w.K + k0 + kc * 8) = o; }
}
__device__ __forceinline__ WItem witem_phase0(unsigned char* wsl, int it) {
    constexpr int I0 = 26 * 32, I1 = 32 * 32, I2 = 8 * 16, I3 = 8 * 8;
    WItem w; int r = it;
    if (r < I0) { w.mat = 0; w.kt = r / 26; w.ng = r % 26; w.K = 2048; w.dst = (bf16_t*)(wsl + OFF_WIN); return w; }
    r -= I0;
    if (r < I1) { w.mat = 1; w.kt = r / 32; w.ng = r % 32; w.K = 2048; w.dst = (bf16_t*)(wsl + OFF_WG); return w; }
    r -= I1;
    if (r < I2) { w.mat = 2; w.kt = r / 8; w.ng = r % 8; w.K = 1024; w.dst = (bf16_t*)(wsl + OFF_WBR); return w; }
    r -= I2;
    if (r < 3 * I3) { const int g = 1 + r / I3; r = r % I3; w.mat = 2 + g; w.kt = r / 8; w.ng = r % 8; w.K = 512; w.dst = (bf16_t*)(wsl + OFF_WBR) + (size_t)2048 * 1024 + (size_t)(g - 1) * 2048 * 512; return w; }
    r -= 3 * I3;
    w.mat = 6; w.kt = r / 8; w.ng = r % 8; w.K = 2048; w.dst = (bf16_t*)(wsl + OFF_WO); return w;
}
__device__ __forceinline__ WItem witem_phase8(unsigned char* wsl, int it) {
    constexpr int I0 = 44 * 32;
    WItem w; int r = it;
    if (r < I0) { w.mat = 7; w.kt = r / 44; w.ng = r % 44; w.K = 2048; w.dst = (bf16_t*)(wsl + OFF_WFF); return w; }
    r -= I0;
    w.mat = 8; w.kt = r / 8; w.ng = r % 8; w.K = FFN; w.dst = (bf16_t*)(wsl + OFF_WD); return w;
}
template <int PH> __device__ __forceinline__ void wconv_run(const Args& a, unsigned char* smem, unsigned char* wsl, int l, int nit, int first = 0) {
    float* tile = (float*)smem;
    const int bid_ = lbid() + first, G = gridDim.x;
    if (bid_ >= nit) return;
    float rg[32];
    WItem cur = PH == 0 ? witem_phase0(wsl, bid_) : witem_phase8(wsl, bid_);
    witem_load(a, l, cur, rg);
    for (int it = bid_; it < nit; it += G) {
        witem_tolds(tile, rg);
        __syncthreads();
        const bool more = it + G < nit;
        WItem nxt = cur;
        if (more) { nxt = PH == 0 ? witem_phase0(wsl, it + G) : witem_phase8(wsl, it + G); witem_load(a, l, nxt, rg); }
        witem_store(cur, tile);
        __syncthreads();
        cur = nxt;
    }
}
__device__ __forceinline__ void wconv_phase0(const Args& a, unsigned char* smem, int l) {
    unsigned char* wsl = launder_ws(a.ws); const int bid_ = lbid();
    constexpr int NIT = 26 * 32 + 32 * 32 + 8 * 16 + 3 * 8 * 8 + 8 * 32;
    wconv_run<0>(a, smem, wsl, l, 26 * 32);
    bf16_t* wl = (bf16_t*)(wsl + OFF_WLORA); bf16_t* wg = (bf16_t*)(wsl + OFF_WGUP);
    const int gt = bid_ * NTHR + ltid(), GT = gridDim.x * NTHR;
    for (int i = gt; i < 2 * 1024 * 256; i += GT) { const int d = i >> 18, np = (i >> 8) & 1023, k = i & 255; float v = 0.f;
        if (np < 512) { if (k < 96) v = a.in[18][((size_t)(l * 2 + d) * 96 + k) * 512 + np]; }
        else { if (k >= 96 && k < 192) v = a.in[20][((size_t)(l * 2 + d) * 96 + (k - 96)) * 512 + (np - 512)]; }
        wl[i] = f2bf(v); }
    for (int i = gt; i < 512 * 256; i += GT) { const int np = i >> 8, k = i & 255; wg[i] = f2bf(a.in[21][((size_t)l * 256 + k) * 512 + np]); }
}
__device__ __forceinline__ void wconv_phase8(const Args& a, unsigned char* smem, int l) {
    unsigned char* wsl = launder_ws(a.ws);
    wconv_run<8>(a, smem, wsl, l, 44 * 32 + 8 * 88);
}
template <bool TOBF, bool COPY = false> __device__ __forceinline__ void rmsnorm_rows(const float* x, const float* g, bf16_t* hout, float* fout, float* xcopy = nullptr) {
    const int tid_ = ltid(), lane = tid_ & 63, wave = tid_ >> 6, bid_ = lbid();
    f32x4 gv[8];
#pragma unroll
    for (int j = 0; j < 8; ++j) gv[j] = ((const f32x4*)g)[lane + 64 * j];
    for (int row = bid_ * 8 + wave; row < M; row += gridDim.x * 8) {
        const f32x4* xr = (const f32x4*)(x + (size_t)row * 2048) + lane;
        f32x4 v[8];
#pragma unroll
        for (int j = 0; j < 8; ++j) v[j] = xr[64 * j];
        asm volatile("" : "+v"(v[0]), "+v"(v[1]), "+v"(v[2]), "+v"(v[3]), "+v"(v[4]), "+v"(v[5]), "+v"(v[6]), "+v"(v[7]));
        float ss = 0.f;
#pragma unroll
        for (int j = 0; j < 8; ++j) ss += (v[j][0] * v[j][0] + v[j][1] * v[j][1]) + (v[j][2] * v[j][2] + v[j][3] * v[j][3]);
        if (COPY) {
#pragma unroll
            for (int j = 0; j < 8; ++j) ((f32x4*)(xcopy + (size_t)row * 2048))[lane + 64 * j] = v[j]; }
        ss = wave_sum(ss, lane);
        const float r = rsqrtf(ss * (1.f / 2048.f) + 1e-6f);
#pragma unroll
        for (int j = 0; j < 8; ++j) { const f32x4 o = v[j] * r * gv[j];
            if (TOBF) { u32x2 w; w.x = pk2(o[0], o[1]); w.y = pk2(o[2], o[3]); ((u32x2*)(hout + (size_t)row * 2048))[lane + 64 * j] = w; }
            else ((f32x4*)(fout + (size_t)row * 2048))[lane + 64 * j] = o; }
    }
}
__device__ __forceinline__ void hid3_and_lam(const Args& a) {
    unsigned char* wsl = launder_ws(a.ws); const int bid_ = lbid();
    const int tid_ = ltid(), lane = tid_ & 63, wave = tid_ >> 6;
    float* hid3 = (float*)(wsl + OFF_HID3);
    for (int it = bid_ * 8 + wave; it < 2 * 2048; it += gridDim.x * 8) {
        const int l = it >> 11, j = it & 2047;
        const float* w1 = a.in[7] + l * 33 * 64; const float* b1 = a.in[8] + l * 64; const float* w2 = a.in[9] + l * 4096; const float* b2 = a.in[10] + l * 64;
        const float* w3 = a.in[11] + l * 4096; const float* b3 = a.in[12] + l * 64; const float fr = a.in[14][l * 64 + lane];
        float ze = 0.f;
        if (lane == 0) ze = (float)j / 2047.f;
        else if (lane < 33) { const int bnd = (lane - 1) & 15; const float band = 1e-4f + (float)bnd * ((15.f - 1e-4f) / 15.f);
            const float ang = ((6.283185307179586f / 2048.f) * (float)j) * band; ze = lane < 17 ? cosf(ang) : -sinf(ang); }
        float acc = b1[lane];
        for (int e = 0; e < 33; ++e) acc += __int_as_float(__builtin_amdgcn_ds_bpermute(e << 2, __float_as_int(ze))) * w1[e * 64 + lane];
        const float h1 = sinf(fr * acc);
        acc = b2[lane];
        for (int e = 0; e < 64; ++e) acc += __int_as_float(__builtin_amdgcn_ds_bpermute(e << 2, __float_as_int(h1))) * w2[e * 64 + lane];
        const float h2 = sinf(fr * acc);
        acc = b3[lane];
        for (int e = 0; e < 64; ++e) acc += __int_as_float(__builtin_amdgcn_ds_bpermute(e << 2, __float_as_int(h2))) * w3[e * 64 + lane];
        hid3[(size_t)it * 64 + lane] = sinf(fr * acc);
    }
    if (bid_ == 0 && wave < 2) { const int l = wave;
        const float s1 = wave_sum(a.in[27][l * 64 + lane] * a.in[28][l * 64 + lane], lane), s2 = wave_sum(a.in[29][l * 64 + lane] * a.in[30][l * 64 + lane], lane);
        const float lam_init = 0.8f - 0.6f * expf(-0.3f * (float)l);
        if (lane == 0) ((float*)(wsl + OFF_LAM))[l] = expf(s1) - expf(s2) + lam_init; }
}
__device__ __forceinline__ float conv3(const bf16_t* bufB, size_t tok, int t, int col, const float* cw, const float* cb) {
    const float u0 = t > 0 ? bf2f(bufB[(tok - 1) * 1536 + col]) : 0.f, u1 = bf2f(bufB[tok * 1536 + col]), u2 = t < T - 1 ? bf2f(bufB[(tok + 1) * 1536 + col]) : 0.f;
    return cw[col] * u0 + cw[1536 + col] * u1 + cw[3072 + col] * u2 + cb[col];
}
__device__ __forceinline__ void tr_store(const bf16_t* tile, bf16_t* dst, size_t rowbase, size_t cmul, int t0) {
    const int tid_ = ltid(), cl = tid_ >> 3, tch = tid_ & 7;
    const u32x4 v = *(const u32x4*)(tile + cl * 72 + tch * 8);
    *(u32x4*)(dst + (rowbase + (size_t)cl * cmul) * T + t0 + tch * 8) = v;
}
__device__ __forceinline__ void prep_phase(const Args& a, unsigned char* smem, int l) {
    unsigned char* wsl = launder_ws(a.ws); const int bid_ = lbid();
    const int tid = ltid(), lane = tid & 63, wave = tid >> 6;
    bf16_t* bufA = (bf16_t*)(wsl + OFF_BUFA); const bf16_t* bufB = (const bf16_t*)(wsl + OFF_BUFB); const bf16_t* bufC = (const bf16_t*)(wsl + OFF_BUFC); const bf16_t* bufD = (const bf16_t*)(wsl + OFF_BUFD);
    {
        const int aa = lane >> 5, i = lane & 31;
        const float invf = exp2f(-(float)(2 * i) * (13.287712379549449f / 64.f));
        const float* qn = a.in[3] + l * 128; const float* kn = a.in[4] + l * 128;
        const float gq0 = qn[aa * 64 + i], gq1 = qn[aa * 64 + 32 + i], gk0 = kn[aa * 64 + i], gk1 = kn[aa * 64 + 32 + i];
        bf16_t* alo = (bf16_t*)(wsl + OFF_ALO); bf16_t* ag = (bf16_t*)(wsl + OFF_AG);
        const float* mu0 = a.in[16] + (size_t)(l * 2 + 0) * 1728; const float* mu1 = a.in[16] + (size_t)(l * 2 + 1) * 1728;
        for (int tok = bid_ * 8 + wave; tok < M; tok += gridDim.x * 8) {
            const int t = tok & (T - 1);
            const float pos = aa == 0 ? (float)(t >> 6) : (float)(t & 63);
            const float ang = pos * invf, cs = cosf(ang), sn = sinf(ang);
            bf16_t* row = bufA + (size_t)tok * 1536;
            float xa[10], xb[10];
#pragma unroll
            for (int hd = 0; hd < 10; ++hd) { const bf16_t* p = row + hd * 128 + aa * 64 + i; xa[hd] = bf2f(p[0]); xb[hd] = bf2f(p[32]); }
#pragma unroll
            for (int hd = 0; hd < 10; ++hd) {
                bf16_t* p = row + hd * 128 + aa * 64 + i;
                const float x0 = xa[hd], x1 = xb[hd];
                const float ss = wave_sum(x0 * x0 + x1 * x1, lane);
                const float r = rsqrtf(ss * (1.f / 128.f) + 1e-6f);
                const float y0 = x0 * r * (hd < 8 ? gq0 : gk0), y1 = x1 * r * (hd < 8 ? gq1 : gk1);
                p[0] = f2bf(y0 * cs - y1 * sn); p[32] = f2bf(y1 * cs + y0 * sn);
            }
            const bf16_t* crow = bufC + (size_t)tok * 2048;
            u32x2 o0 = {0u, 0u}, o1 = {0u, 0u};
            if (lane < 48) {
                const int col = 1536 + lane * 4;
                const u32x2 xc = *(const u32x2*)(crow + col);
                u32x2 xp = {0u, 0u}, xn = {0u, 0u};
                if (t > 0) xp = *(const u32x2*)(crow - 2048 + col);
                if (t < T - 1) xn = *(const u32x2*)(crow + 2048 + col);
                const float c4[4] = {bflo(xc.x), bfhi(xc.x), bflo(xc.y), bfhi(xc.y)};
                const float p4[4] = {bflo(xp.x), bfhi(xp.x), bflo(xp.y), bfhi(xp.y)};
                const float n4[4] = {bflo(xn.x), bfhi(xn.x), bflo(xn.y), bfhi(xn.y)};
                float f0[4], f1[4];
#pragma unroll
                for (int j = 0; j < 4; ++j) { f0[j] = c4[j] + (p4[j] - c4[j]) * mu0[col + j]; f1[j] = c4[j] + (n4[j] - c4[j]) * mu1[col + j];
                    if (lane < 24) { f0[j] = tanhf(f0[j]); f1[j] = tanhf(f1[j]); } }
                o0.x = pk2(f0[0], f0[1]); o0.y = pk2(f0[2], f0[3]); o1.x = pk2(f1[0], f1[1]); o1.y = pk2(f1[2], f1[3]);
            }
            *(u32x2*)(alo + (size_t)tok * 256 + lane * 4) = o0;
            *(u32x2*)(alo + (size_t)(M + tok) * 256 + lane * 4) = o1;
            { const u32x2 xg = *(const u32x2*)(crow + 1728 + lane * 4); u32x2 og;
              og.x = pk2(sigmoidf_(bflo(xg.x)), sigmoidf_(bfhi(xg.x))); og.y = pk2(sigmoidf_(bflo(xg.y)), sigmoidf_(bfhi(xg.y)));
              *(u32x2*)(ag + (size_t)tok * 256 + lane * 4) = og; }
        }
    }
    __syncthreads();
    {
        bf16_t* tile = (bf16_t*)smem;
        bf16_t* zT = (bf16_t*)(wsl + OFF_ZT); bf16_t* vta = (bf16_t*)(wsl + OFF_VTA); bf16_t* vtd = (bf16_t*)(wsl + OFF_VTD);
        const float* cw = a.in[5] + (size_t)l * 3 * 1536; const float* cb = a.in[6] + (size_t)l * 1536;
        const int tl = tid >> 3, c0l = (tid & 7) * 8;
        constexpr int NZ = 8 * 32 * 8, NA = 8 * 32 * 4, ND = 8 * 32 * 8;
        for (int it = bid_; it < NZ + NA + ND; it += gridDim.x) {
            int r = it;
            if (r < NZ) { const int cb_ = r & 7, tb = (r >> 3) & 31, b = r >> 8; const int t = tb * 64 + tl; const size_t tok = (size_t)b * T + t;
                float cv[2][8];
#pragma unroll
                for (int grp = 0; grp < 2; ++grp) { const int col = grp * 512 + cb_ * 64 + c0l;
                    const u32x4 u1 = *(const u32x4*)(bufB + tok * 1536 + col);
                    u32x4 u0 = {0u, 0u, 0u, 0u}, u2 = {0u, 0u, 0u, 0u};
                    if (t > 0) u0 = *(const u32x4*)(bufB + (tok - 1) * 1536 + col);
                    if (t < T - 1) u2 = *(const u32x4*)(bufB + (tok + 1) * 1536 + col);
                    const f32x4 w0a = *(const f32x4*)(cw + col), w0b = *(const f32x4*)(cw + col + 4), w1a = *(const f32x4*)(cw + 1536 + col), w1b = *(const f32x4*)(cw + 1536 + col + 4);
                    const f32x4 w2a = *(const f32x4*)(cw + 3072 + col), w2b = *(const f32x4*)(cw + 3072 + col + 4), ba = *(const f32x4*)(cb + col), bb = *(const f32x4*)(cb + col + 4);
                    const unsigned p0[4] = {u0.x, u0.y, u0.z, u0.w}, p1[4] = {u1.x, u1.y, u1.z, u1.w}, p2[4] = {u2.x, u2.y, u2.z, u2.w};
#pragma unroll
                    for (int j = 0; j < 4; ++j) { const float wl0 = j < 2 ? w0a[2 * j] : w0b[2 * j - 4], wh0 = j < 2 ? w0a[2 * j + 1] : w0b[2 * j - 3];
                        const float wl1 = j < 2 ? w1a[2 * j] : w1b[2 * j - 4], wh1 = j < 2 ? w1a[2 * j + 1] : w1b[2 * j - 3];
                        const float wl2 = j < 2 ? w2a[2 * j] : w2b[2 * j - 4], wh2 = j < 2 ? w2a[2 * j + 1] : w2b[2 * j - 3];
                        const float bl = j < 2 ? ba[2 * j] : bb[2 * j - 4], bh = j < 2 ? ba[2 * j + 1] : bb[2 * j - 3];
                        cv[grp][2 * j] = wl0 * bflo(p0[j]) + wl1 * bflo(p1[j]) + wl2 * bflo(p2[j]) + bl;
                        cv[grp][2 * j + 1] = wh0 * bfhi(p0[j]) + wh1 * bfhi(p1[j]) + wh2 * bfhi(p2[j]) + bh; } }
#pragma unroll
                for (int j = 0; j < 8; ++j) tile[(c0l + j) * 72 + tl] = f2bf(cv[0][j] * cv[1][j]);
                __syncthreads();
                tr_store(tile, zT, (size_t)(cb_ * 64) * 8 + b, 8, tb * 64);
                __syncthreads(); continue; }
            r -= NZ;
            if (r < NA) { const int cb_ = r & 3, tb = (r >> 2) & 31, b = r >> 7;
                const u32x4 v = *(const u32x4*)(bufA + ((size_t)b * T + tb * 64 + tl) * 1536 + 1280 + cb_ * 64 + c0l);
                const unsigned pv[4] = {v.x, v.y, v.z, v.w};
#pragma unroll
                for (int j = 0; j < 4; ++j) { tile[(c0l + 2 * j) * 72 + tl] = (bf16_t)(pv[j] & 0xffffu); tile[(c0l + 2 * j + 1) * 72 + tl] = (bf16_t)(pv[j] >> 16); }
                __syncthreads();
                tr_store(tile, vta, (size_t)b * 256 + cb_ * 64, 1, tb * 64);
                __syncthreads(); continue; }
            r -= NA;
            { const int cb_ = r & 7, tb = (r >> 3) & 31, b = r >> 8;
                const u32x4 v = *(const u32x4*)(bufD + ((size_t)b * T + tb * 64 + tl) * 1536 + 1024 + cb_ * 64 + c0l);
                const unsigned pv[4] = {v.x, v.y, v.z, v.w};
#pragma unroll
                for (int j = 0; j < 4; ++j) { tile[(c0l + 2 * j) * 72 + tl] = (bf16_t)(pv[j] & 0xffffu); tile[(c0l + 2 * j + 1) * 72 + tl] = (bf16_t)(pv[j] >> 16); }
                __syncthreads();
                tr_store(tile, vtd, (size_t)b * 512 + cb_ * 64, 1, tb * 64);
                __syncthreads(); }
        }
    }
}
__device__ __forceinline__ void scan_item(const Args& a, unsigned char* smem, int l, int item) {
    unsigned char* wsl = launder_ws(a.ws);
    int tid = threadIdx.x; asm volatile("" : "+v"(tid));
    const int dir = item & 1, h = (item >> 1) & 7, b = item >> 4;
    constexpr int BUFSZ = 7 * 1024 + 16;
    float* lds = (float*)smem;
    const bf16_t* bufC = (const bf16_t*)(wsl + OFF_BUFC);
    const bf16_t* sla = (const bf16_t*)(wsl + OFF_SLD) + (size_t)dir * M * 1024;
    bf16_t* oc = (bf16_t*)(wsl + OFF_OCDIR) + (size_t)dir * M * 512;
    const bool is_prod = tid >= 256;
    const int t8 = tid & 255, lane = tid & 63;
    const int pt0 = t8 >> 5, kp = t8 & 31, colr = h * 64 + 2 * kp;
    float w00 = 0.f, w01 = 0.f, a00 = 0.f, a01 = 0.f, mur0 = 0.f, mur1 = 0.f, muk0 = 0.f, muk1 = 0.f, muv0 = 0.f, muv1 = 0.f, kk0 = 0.f, kk1 = 0.f, ka0 = 0.f, ka1 = 0.f, rk0 = 0.f, rk1 = 0.f, lw0 = 0.f, lw1 = 0.f, lb0 = 0.f, lb1 = 0.f;
    if (is_prod) {
        w00 = a.in[17][(l * 2 + dir) * 512 + colr]; w01 = a.in[17][(l * 2 + dir) * 512 + colr + 1];
        a00 = a.in[19][(l * 2 + dir) * 512 + colr]; a01 = a.in[19][(l * 2 + dir) * 512 + colr + 1];
        const float* mu = a.in[16] + (size_t)(l * 2 + dir) * 1728;
        mur0 = mu[colr]; mur1 = mu[colr + 1]; muk0 = mu[512 + colr]; muk1 = mu[512 + colr + 1]; muv0 = mu[1024 + colr]; muv1 = mu[1024 + colr + 1];
        kk0 = a.in[22][l * 512 + colr]; kk1 = a.in[22][l * 512 + colr + 1]; ka0 = a.in[23][l * 512 + colr]; ka1 = a.in[23][l * 512 + colr + 1];
        rk0 = a.in[24][l * 512 + colr]; rk1 = a.in[24][l * 512 + colr + 1];
        lw0 = a.in[25][l * 512 + colr]; lw1 = a.in[25][l * 512 + colr + 1]; lb0 = a.in[26][l * 512 + colr]; lb1 = a.in[26][l * 512 + colr + 1];
    }
    const int cvp = t8 >> 3, ks = t8 & 7;
    typedef float f32x2s __attribute__((ext_vector_type(2)));
    f32x2s S2[8];
#pragma unroll
    for (int j = 0; j < 8; ++j) S2[j] = (f32x2s){0.f, 0.f};
    unsigned xr[2], xk[2], xv[2], sr[2], sk[2], sv[2], xl[2], xa[2];
#define SCAN_LOAD(c) do { _Pragma("unroll") for (int pp = 0; pp < 2; ++pp) { const int s_ = (c) * 16 + pt0 + 8 * pp; const int t_ = dir ? (T - 1 - s_) : s_; const int ts_ = dir ? t_ + 1 : t_ - 1; const size_t tok_ = (size_t)b * T + t_; \
        const bf16_t* p_ = bufC + tok_ * 2048 + colr; xr[pp] = *(const unsigned*)p_; xk[pp] = *(const unsigned*)(p_ + 512); xv[pp] = *(const unsigned*)(p_ + 1024); \
        sr[pp] = 0u; sk[pp] = 0u; sv[pp] = 0u; if (ts_ >= 0 && ts_ < T) { const bf16_t* q_ = bufC + ((size_t)b * T + ts_) * 2048 + colr; sr[pp] = *(const unsigned*)q_; sk[pp] = *(const unsigned*)(q_ + 512); sv[pp] = *(const unsigned*)(q_ + 1024); } \
        xl[pp] = *(const unsigned*)(sla + tok_ * 1024 + colr); xa[pp] = *(const unsigned*)(sla + tok_ * 1024 + 512 + colr); } } while (0)
#define SCAN_PRODUCE(bufp) do { float* R_ = (bufp); float* W_ = R_ + 1024; float* K_ = W_ + 1024; float* A_ = K_ + 1024; float* B_ = A_ + 1024; float* V_ = B_ + 1024; float* SB_ = V_ + 2048; \
        _Pragma("unroll") for (int pp = 0; pp < 2; ++pp) { const int ptl = pt0 + 8 * pp; \
            const float r0 = bflo(xr[pp]) + (bflo(sr[pp]) - bflo(xr[pp])) * mur0, r1 = bfhi(xr[pp]) + (bfhi(sr[pp]) - bfhi(xr[pp])) * mur1; \
            const float k0 = bflo(xk[pp]) + (bflo(sk[pp]) - bflo(xk[pp])) * muk0, k1 = bfhi(xk[pp]) + (bfhi(sk[pp]) - bfhi(xk[pp])) * muk1; \
            const float v0 = bflo(xv[pp]) + (bflo(sv[pp]) - bflo(xv[pp])) * muv0, v1 = bfhi(xv[pp]) + (bfhi(sv[pp]) - bfhi(xv[pp])) * muv1; \
            const float a0 = sigmoidf_(a00 + bflo(xa[pp])), a1 = sigmoidf_(a01 + bfhi(xa[pp])); \
            const float q0 = k0 * kk0, q1 = k1 * kk1; \
            const float ss = half_sum(q0 * q0 + q1 * q1, lane); \
            const float inv = 1.f / fmaxf(sqrtf(ss), 1e-12f); \
            const float n0 = q0 * inv, n1 = q1 * inv; \
            const float kn0 = k0 * (1.f + (a0 - 1.f) * ka0), kn1 = k1 * (1.f + (a1 - 1.f) * ka1); \
            const float sb = half_sum(r0 * kn0 * rk0 + r1 * kn1 * rk1, lane); \
            const int o = ptl * 64 + 2 * kp; \
            *(float2*)(R_ + o) = make_float2(r0, r1); \
            *(float2*)(W_ + o) = make_float2(__expf(-0.60653065971f * sigmoidf_(w00 + bflo(xl[pp]))), __expf(-0.60653065971f * sigmoidf_(w01 + bfhi(xl[pp])))); \
            *(float2*)(K_ + o) = make_float2(kn0, kn1); \
            *(float2*)(A_ + o) = make_float2(-n0, -n1); \
            *(float2*)(B_ + o) = make_float2(n0 * a0, n1 * a1); \
            *(float2*)(V_ + o) = make_float2(v0, v1); \
            if (kp == 0) SB_[ptl] = sb; } } while (0)
    if (is_prod) { SCAN_LOAD(0); SCAN_PRODUCE(lds); SCAN_LOAD(1); }
    __syncthreads();
    for (int c = 0; c < 128; ++c) {
        float* cur = lds + (c & 1) * BUFSZ; float* oth = lds + ((c & 1) ^ 1) * BUFSZ;
        if (!is_prod) {
            const float* R = cur; const float* W = R + 1024; const float* Kx = W + 1024; const float* Ax = Kx + 1024; const float* Bx = Ax + 1024; const float* Vx = Bx + 1024; float* Ox = cur + 6 * 1024;
#define SC_DECL(P) f32x4 P##a0, P##a1, P##w0, P##w1, P##b0, P##b1, P##k0, P##k1, P##r0, P##r1; float2 P##vv
#define SC_LOAD(P, tl) do { P##vv = *(const float2*)(Vx + (tl) * 64 + 2 * cvp); \
                P##a0 = *(const f32x4*)(Ax + (tl) * 64 + ks * 8); P##a1 = *(const f32x4*)(Ax + (tl) * 64 + ks * 8 + 4); \
                P##w0 = *(const f32x4*)(W + (tl) * 64 + ks * 8); P##w1 = *(const f32x4*)(W + (tl) * 64 + ks * 8 + 4); \
                P##b0 = *(const f32x4*)(Bx + (tl) * 64 + ks * 8); P##b1 = *(const f32x4*)(Bx + (tl) * 64 + ks * 8 + 4); \
                P##k0 = *(const f32x4*)(Kx + (tl) * 64 + ks * 8); P##k1 = *(const f32x4*)(Kx + (tl) * 64 + ks * 8 + 4); \
                P##r0 = *(const f32x4*)(R + (tl) * 64 + ks * 8); P##r1 = *(const f32x4*)(R + (tl) * 64 + ks * 8 + 4); } while (0)
#define SC_STEP(P, tl) do { \
                f32x2s sa = (S2[0] * P##a0[0] + S2[1] * P##a0[1]) + (S2[2] * P##a0[2] + S2[3] * P##a0[3]); \
                f32x2s sb_ = (S2[4] * P##a1[0] + S2[5] * P##a1[1]) + (S2[6] * P##a1[2] + S2[7] * P##a1[3]); \
                sa = sa + sb_; \
                sa.x = sum8(sa.x); sa.y = sum8(sa.y); \
                const f32x2s vv2 = {P##vv.x, P##vv.y}; \
                _Pragma("unroll") for (int j = 0; j < 4; ++j) { \
                    S2[j] = S2[j] * P##w0[j] + (sa * P##b0[j] + vv2 * P##k0[j]); S2[4 + j] = S2[4 + j] * P##w1[j] + (sa * P##b1[j] + vv2 * P##k1[j]); } \
                f32x2s oo = (S2[0] * P##r0[0] + S2[1] * P##r0[1]) + (S2[2] * P##r0[2] + S2[3] * P##r0[3]); \
                f32x2s ob_ = (S2[4] * P##r1[0] + S2[5] * P##r1[1]) + (S2[6] * P##r1[2] + S2[7] * P##r1[3]); \
                oo = oo + ob_; \
                oo.x = sum8(oo.x); oo.y = sum8(oo.y); \
                if (ks == 0) *(float2*)(Ox + (tl) * 64 + 2 * cvp) = make_float2(oo.x, oo.y); } while (0)
            SC_DECL(pa_); SC_DECL(pb_);
            SC_LOAD(pa_, 0);
#pragma unroll 1
            for (int tl = 0; tl < 16; tl += 2) {
                SC_LOAD(pb_, tl + 1);
                SC_STEP(pa_, tl);
                if (tl + 2 < 16) SC_LOAD(pa_, tl + 2);
                SC_STEP(pb_, tl + 1);
            }
#undef SC_DECL
#undef SC_LOAD
#undef SC_STEP
        } else {
            if (c > 0) {
                const float* Ox = oth + 6 * 1024; const float* Vx = oth + 5 * 1024; const float* SB = oth + 7 * 1024;
#pragma unroll
                for (int pp = 0; pp < 2; ++pp) { const int ptl = pt0 + 8 * pp;
                    const float2 ov = *(const float2*)(Ox + ptl * 64 + 2 * kp);
                    const float mean = half_sum(ov.x + ov.y, lane) * (1.f / 64.f);
                    const float d0 = ov.x - mean, d1 = ov.y - mean;
                    const float var = half_sum(d0 * d0 + d1 * d1, lane) * (1.f / 64.f);
                    const float rs = rsqrtf(var + 64e-5f);
                    const float2 vv = *(const float2*)(Vx + ptl * 64 + 2 * kp); const float sb = SB[ptl];
                    const float y0 = d0 * rs * lw0 + lb0 + sb * vv.x, y1 = d1 * rs * lw1 + lb1 + sb * vv.y;
                    const int s_ = (c - 1) * 16 + ptl; const int t_ = dir ? (T - 1 - s_) : s_;
                    *(unsigned*)(oc + ((size_t)b * T + t_) * 512 + colr) = pk2(y0, y1); }
            }
            if (c + 1 < 128) { SCAN_PRODUCE(oth); if (c + 2 < 128) SCAN_LOAD(c + 2); }
        }
        __syncthreads();
    }
    if (is_prod) {
        const float* fin = lds + (127 & 1) * BUFSZ; const float* Ox = fin + 6 * 1024; const float* Vx = fin + 5 * 1024; const float* SB = fin + 7 * 1024;
#pragma unroll
        for (int pp = 0; pp < 2; ++pp) { const int ptl = pt0 + 8 * pp;
            const float2 ov = *(const float2*)(Ox + ptl * 64 + 2 * kp);
            const float mean = half_sum(ov.x + ov.y, lane) * (1.f / 64.f);
            const float d0 = ov.x - mean, d1 = ov.y - mean;
            const float var = half_sum(d0 * d0 + d1 * d1, lane) * (1.f / 64.f);
            const float rs = rsqrtf(var + 64e-5f);
            const float2 vv = *(const float2*)(Vx + ptl * 64 + 2 * kp); const float sb = SB[ptl];
            const float y0 = d0 * rs * lw0 + lb0 + sb * vv.x, y1 = d1 * rs * lw1 + lb1 + sb * vv.y;
            const int s_ = 127 * 16 + ptl; const int t_ = dir ? (T - 1 - s_) : s_;
            *(unsigned*)(oc + ((size_t)b * T + t_) * 512 + colr) = pk2(y0, y1); }
    }
    __syncthreads();
#undef SCAN_LOAD
#undef SCAN_PRODUCE
}
template <int DQK, int MODE>
__device__ __forceinline__ void attn_item(unsigned char* smem, const bf16_t* Q, int ldq, const bf16_t* Kg, int ldk, const bf16_t* Vt, float sc, float slope, int q0,
                                          bf16_t* O, int ldo, float lam, const float* subln, float outmul) {
    constexpr int KST = DQK * 2 + 16, VST = 144, KBYTES = 64 * KST, VBYTES = 128 * VST, NKK = DQK / 16, KCH = DQK / 8, KLD = KCH / 8;
    int tid = threadIdx.x; asm volatile("" : "+v"(tid));
    const int lane = tid & 63, wave = tid >> 6, r = lane & 31, h = lane >> 5;
#define Kb_(x) (smem + (x) * KBYTES)
#define Vb_(x) (smem + 2 * KBYTES + (x) * VBYTES)
    bf16x8 qf[NKK];
    { const bf16_t* qp = Q + (size_t)(wave * 32 + r) * ldq + 8 * h;
#pragma unroll
      for (int kk = 0; kk < NKK; ++kk) { const u32x4 qv = *(const u32x4*)(qp + 16 * kk); u32x4 w;
          w.x = pk2(bflo(qv.x) * sc, bfhi(qv.x) * sc); w.y = pk2(bflo(qv.y) * sc, bfhi(qv.y) * sc); w.z = pk2(bflo(qv.z) * sc, bfhi(qv.z) * sc); w.w = pk2(bflo(qv.w) * sc, bfhi(qv.w) * sc);
          qf[kk] = __builtin_bit_cast(bf16x8, w); } }
    f32x16 o[4];
#pragma unroll
    for (int i = 0; i < 4; ++i)
#pragma unroll
        for (int j = 0; j < 16; ++j) o[i][j] = 0.f;
    float m_run = -1e30f, l_run = 0.f;
    u32x4 kreg[2];
#define ATT_LOADK(kt) do { _Pragma("unroll") for (int i_ = 0; i_ < KLD; ++i_) { const int id_ = tid + 512 * i_, row_ = id_ / KCH, ch_ = id_ % KCH; kreg[i_] = *(const u32x4*)(Kg + (size_t)((kt) * 64 + row_) * ldk + ch_ * 8); } } while (0)
#define ATT_LOADV(kt) do { _Pragma("unroll") for (int i_ = 0; i_ < 2; ++i_) { const int id_ = tid + 512 * i_, row_ = id_ >> 3, ch_ = id_ & 7; kreg[i_] = *(const u32x4*)(Vt + (size_t)row_ * T + (kt) * 64 + ch_ * 8); } } while (0)
#define ATT_STOREK(bi) do { _Pragma("unroll") for (int i_ = 0; i_ < KLD; ++i_) { const int id_ = tid + 512 * i_, row_ = id_ / KCH, ch_ = id_ % KCH; *(u32x4*)(Kb_(bi) + row_ * KST + ch_ * 16) = kreg[i_]; } } while (0)
#define ATT_STOREV(bi) do { _Pragma("unroll") for (int i_ = 0; i_ < 2; ++i_) { const int id_ = tid + 512 * i_, row_ = id_ >> 3, ch_ = id_ & 7; *(u32x4*)(Vb_(bi) + row_ * VST + ch_ * 16) = kreg[i_]; } } while (0)
    __syncthreads();
    ATT_LOADK(0); ATT_STOREK(0); ATT_LOADV(0); ATT_STOREV(0);
    __syncthreads();
    const int qpos = q0 + wave * 32 + r;
    for (int kt = 0; kt < 32; ++kt) {
        const int bi = kt & 1;
#pragma unroll
        for (int kb = 0; kb < 2; ++kb) {
            if (kt + 1 < 32) { if (kb == 0) ATT_LOADK(kt + 1); else { ATT_STOREK(bi ^ 1); ATT_LOADV(kt + 1); } }
            f32x16 s;
#pragma unroll
            for (int j = 0; j < 16; ++j) s[j] = 0.f;
#pragma unroll
            for (int kk = 0; kk < NKK; ++kk) { const bf16x8 af = *(const bf16x8*)(Kb_(bi) + (32 * kb + r) * KST + (16 * kk + 8 * h) * 2);
                s = __builtin_amdgcn_mfma_f32_32x32x16_bf16(af, qf[kk], s, 0, 0, 0); }
            float mt = -1e30f;
            if (slope != 0.f) { const float dq = (float)(qpos - kt * 64 - 4 * h - 32 * kb);
#pragma unroll
                for (int j = 0; j < 16; ++j) { const float dd = dq - (float)((j & 3) + 8 * (j >> 2)); s[j] = fmaf(-slope, fabsf(dd), s[j]); mt = fmaxf(mt, s[j]); }
            } else {
#pragma unroll
                for (int j = 0; j < 16; ++j) mt = fmaxf(mt, s[j]);
            }
            mt = fmaxf(mt, shx(mt, 32, lane));
            const float m_new = fmaxf(m_run, mt), alpha = __builtin_amdgcn_exp2f(m_run - m_new);
            m_run = m_new;
            float psum = 0.f;
#pragma unroll
            for (int j = 0; j < 16; ++j) { s[j] = __builtin_amdgcn_exp2f(s[j] - m_new); psum += s[j]; }
            l_run = l_run * alpha + psum;
            if (__builtin_amdgcn_ballot_w64(alpha != 1.0f) != 0ull) {
#pragma unroll
                for (int i = 0; i < 4; ++i) o[i] = o[i] * alpha; }
            bf16x8 pf[2];
#pragma unroll
            for (int s2 = 0; s2 < 2; ++s2) { u32x4 w; w.x = pk2(s[8 * s2 + 0], s[8 * s2 + 1]); w.y = pk2(s[8 * s2 + 2], s[8 * s2 + 3]);
                w.z = pk2(s[8 * s2 + 4], s[8 * s2 + 5]); w.w = pk2(s[8 * s2 + 6], s[8 * s2 + 7]); pf[s2] = __builtin_bit_cast(bf16x8, w); }
#pragma unroll
            for (int dvb = 0; dvb < 4; ++dvb)
#pragma unroll
                for (int s2 = 0; s2 < 2; ++s2) { const unsigned char* vp = Vb_(bi) + (32 * dvb + r) * VST + (32 * kb + 16 * s2 + 4 * h) * 2;
                    const u32x2 lo = *(const u32x2*)vp, hi = *(const u32x2*)(vp + 16); u32x4 w; w.x = lo.x; w.y = lo.y; w.z = hi.x; w.w = hi.y;
                    o[dvb] = __builtin_amdgcn_mfma_f32_32x32x16_bf16(__builtin_bit_cast(bf16x8, w), pf[s2], o[dvb], 0, 0, 0); }
        }
        if (kt + 1 < 32) ATT_STOREV(bi ^ 1);
        __syncthreads();
    }
#undef ATT_LOADK
#undef ATT_LOADV
#undef ATT_STOREK
#undef ATT_STOREV
#undef Kb_
#undef Vb_
    const float lt = l_run + shx(l_run, 32, lane), inv = 1.f / lt;
    bf16_t* orow = O + (size_t)(wave * 32 + r) * ldo;
    unsigned char* stash = smem + 73728 + tid * 128;
    if (MODE == 0) {
#pragma unroll
        for (int dvb = 0; dvb < 4; ++dvb)
#pragma unroll
            for (int g = 0; g < 4; ++g) { u32x2 w; w.x = pk2(o[dvb][4 * g] * inv, o[dvb][4 * g + 1] * inv); w.y = pk2(o[dvb][4 * g + 2] * inv, o[dvb][4 * g + 3] * inv);
                *(u32x2*)(orow + 32 * dvb + 8 * g + 4 * h) = w; }
    } else if (MODE == 1) {
#pragma unroll
        for (int dvb = 0; dvb < 4; ++dvb)
#pragma unroll
            for (int g = 0; g < 4; ++g) { u32x2 w; w.x = pk2(o[dvb][4 * g] * inv, o[dvb][4 * g + 1] * inv); w.y = pk2(o[dvb][4 * g + 2] * inv, o[dvb][4 * g + 3] * inv);
                *(u32x2*)(stash + (4 * dvb + g) * 8) = w; }
    } else {
        float ss = 0.f;
#pragma unroll
        for (int dvb = 0; dvb < 4; ++dvb)
#pragma unroll
            for (int g = 0; g < 4; ++g) { const u32x2 pv = *(const u32x2*)(stash + (4 * dvb + g) * 8);
                o[dvb][4 * g] = bflo(pv.x) - lam * o[dvb][4 * g] * inv; o[dvb][4 * g + 1] = bfhi(pv.x) - lam * o[dvb][4 * g + 1] * inv;
                o[dvb][4 * g + 2] = bflo(pv.y) - lam * o[dvb][4 * g + 2] * inv; o[dvb][4 * g + 3] = bfhi(pv.y) - lam * o[dvb][4 * g + 3] * inv;
#pragma unroll
                for (int j = 0; j < 4; ++j) ss += o[dvb][4 * g + j] * o[dvb][4 * g + j]; }
        ss += shx(ss, 32, lane);
        const float rs = rsqrtf(ss * (1.f / 128.f) + 1e-6f) * outmul;
#pragma unroll
        for (int dvb = 0; dvb < 4; ++dvb)
#pragma unroll
            for (int g = 0; g < 4; ++g) { const f32x4 gv = *(const f32x4*)(subln + 32 * dvb + 8 * g + 4 * h); u32x2 w;
                w.x = pk2(o[dvb][4 * g] * rs * gv[0], o[dvb][4 * g + 1] * rs * gv[1]); w.y = pk2(o[dvb][4 * g + 2] * rs * gv[2], o[dvb][4 * g + 3] * rs * gv[3]);
                *(u32x2*)(orow + 32 * dvb + 8 * g + 4 * h) = w; }
    }
}
__device__ __forceinline__ void hyena_item(const Args& a, unsigned char* smem, int l, int c) {
    unsigned char* wsl = launder_ws(a.ws);
    constexpr int CST = 4112;
    int tid = threadIdx.x; asm volatile("" : "+v"(tid));
    const int lane = tid & 63, wave = tid >> 6;
    float* HF = (float*)smem; float* HB = HF + 2048; float* red = HB + 2048;
    float* w4s = red + 16;
    bf16_t* E = (bf16_t*)(smem + 16384 + 1024);
    bf16_t* zs = E + 8 * CST;
    constexpr int ZST = 2056;
    const float* hid3 = (const float*)(wsl + OFF_HID3) + (size_t)l * 2048 * 64;
    const float* w4 = a.in[13] + (size_t)l * 64 * 1024;
    __syncthreads();
    if (tid < 128) w4s[tid] = w4[(tid & 63) * 1024 + (tid >> 6) * 512 + c];
    __syncthreads();
    const float delta = fabsf(-3.0701134573253946f + (-15.350567286626972f + 3.0701134573253946f) * ((float)c / 511.f));
    float asum = 0.f;
#pragma unroll 1
    for (int rr = 0; rr < 4; ++rr) { const int j = tid + 512 * rr; const f32x4* hp = (const f32x4*)(hid3 + (size_t)j * 64);
        float f = 0.f, bk = 0.f;
#pragma unroll
        for (int q = 0; q < 16; ++q) { const f32x4 hv = hp[q];
#pragma unroll
            for (int e = 0; e < 4; ++e) { f += hv[e] * w4s[4 * q + e]; bk += hv[e] * w4s[64 + 4 * q + e]; } }
        const float win = __expf(-((float)j / 2047.f) * delta);
        f *= win; bk *= win; HF[j] = f; HB[j] = bk; asum += fabsf(f) + (j > 0 ? fabsf(bk) : 0.f); }
    asum = wave_sum(asum, lane);
    if (lane == 0) red[wave] = asum;
    { const bf16_t* zT = (const bf16_t*)(wsl + OFF_ZT) + (size_t)c * 8 * 2048;
#pragma unroll
      for (int i = 0; i < 4; ++i) { const int id = tid + 512 * i, bb = id >> 8, ch = id & 255; *(u32x4*)(zs + bb * ZST + ch * 8) = *(const u32x4*)(zT + (size_t)bb * 2048 + ch * 8); } }
    __syncthreads();
    float tot = 0.f;
#pragma unroll
    for (int i = 0; i < 8; ++i) tot += red[i];
    const float invn = 1.f / tot;
    for (int idx = tid; idx < 8 * 4096; idx += NTHR) { const int u = idx >> 12, ip = idx & 4095, i = ip - u; float v = 0.f;
        if (i >= 1 && i <= 4095) { const int d = 2048 - i; v = (d >= 0 ? HF[d] : HB[-d]) * invn; }
        E[u * CST + ip] = f2bf(v); }
    __syncthreads();
    float* yT = (float*)(wsl + OFF_YT) + (size_t)c * 8 * 2048;
    const int m = lane & 15, q = lane >> 4;
    const bf16_t* Eu = E + (m & 7) * CST + 2048 + 8 * q - (m & 8);
    const bf16_t* zrow = zs + (m & 7) * ZST + 8 * q;
#pragma unroll 1
    for (int g = 0; g < 4; ++g) {
        const int tt0 = wave * 16 + g * 4;
        f32x4 acc[4];
#pragma unroll
        for (int i = 0; i < 4; ++i) acc[i] = (f32x4){0.f, 0.f, 0.f, 0.f};
#pragma unroll 2
        for (int ss = 0; ss < 64; ++ss) { const int s0 = ss * 32;
            bf16x8 bz = *(const bf16x8*)(zrow + s0);
            if (m >= 8) bz = (bf16x8){0, 0, 0, 0, 0, 0, 0, 0};
#pragma unroll
            for (int i = 0; i < 4; ++i) { const bf16x8 af = *(const bf16x8*)(Eu - (tt0 + i) * 16 + s0);
                acc[i] = __builtin_amdgcn_mfma_f32_16x16x32_bf16(af, bz, acc[i], 0, 0, 0); } }
        if (m < 8) {
#pragma unroll
            for (int i = 0; i < 4; ++i) *(f32x4*)(yT + (size_t)m * 2048 + (tt0 + i) * 16 + 4 * q) = acc[i]; }
    }
    __syncthreads();
}
#if defined(DBG_STOP)
#ifndef PH_MASK
#define PH_MASK ((2 << (DBG_STOP >= 40 ? 4 : DBG_STOP)) - 1)
#endif
#define DBG_LAYERS 1
#ifndef DBG_NL
#define DBG_NL 1
#endif
#define NLAYER DBG_NL
#else
#define NLAYER 2
#endif
#ifndef PH_MASK
#define PH_MASK 0xFFF
#endif
#ifndef PH_MASK0
#define PH_MASK0 0xFFF
#endif
#ifndef PH_DUP
#define PH_DUP 0
#endif
__device__ __forceinline__ void mixers_phase(const Args& a, unsigned char* smem, int l) {
    unsigned char* wsl = launder_ws(a.ws); const int bid_ = lbid();
    constexpr int N_SCAN = 128, N_D = 256, N_A = 512, N_H = 512, N_W8 = 44 * 32 + 8 * 88, N_W0 = 32 * 32 + 8 * 16 + 3 * 8 * 8 + 8 * 32, N_ALL = N_SCAN + 4 * (N_D + N_A + N_H);
    static_assert(3 * (N_D + N_A + N_H) >= N_W8 + N_W0, "memory item slots");
    unsigned* ctr = (unsigned*)(wsl + OFF_CTL) + 64 * (1 + l);
    int* sh = (int*)(smem + LDS_BYTES - 16);
    const float LOG2E = 1.4426950408889634f;
    for (;;) {
        __syncthreads();
        if (ltid() == 0) sh[0] = (int)atomicAdd(ctr, 1u);
        __syncthreads();
        const int it = __builtin_amdgcn_readfirstlane(sh[0]);
        if (it >= N_ALL) break;
        if (it < N_SCAN) { scan_item(a, smem, l, it); continue; }
        const int q = it - N_SCAN, grp = q >> 2, j = q & 3;
        if (j < 3) {
            const int m = grp * 3 + j;
            if (m >= N_W8 + N_W0) continue;
            const WItem w = m < N_W8 ? witem_phase8(wsl, m) : witem_phase0(wsl, 26 * 32 + (m - N_W8)); float rg[32];
            witem_load(a, l, w, rg); witem_tolds((float*)smem, rg);
            __syncthreads();
            witem_store(w, (const float*)smem);
            continue;
        }
        int r = grp;
        if (r < N_D) {
            const int qb = r & 7, hd = (r >> 3) & 3, b = r >> 5;
            const bf16_t* bufD = (const bf16_t*)(wsl + OFF_BUFD) + (size_t)b * T * 1536;
            const bf16_t* vt = (const bf16_t*)(wsl + OFF_VTD) + ((size_t)b * 512 + hd * 128) * T;
            bf16_t* od = (bf16_t*)(wsl + OFF_OD) + ((size_t)b * T + qb * 256) * 512 + hd * 128;
            const float slope = exp2f(-2.f * (float)(hd + 1)) * LOG2E, sc = 0.125f * LOG2E;
            const float lam = ((const float*)(wsl + OFF_LAM))[l];
            const float lam_init = 0.8f - 0.6f * expf(-0.3f * (float)l);
            attn_item<64, 1>(smem, bufD + (size_t)qb * 256 * 1536 + hd * 128, 1536, bufD + 512 + hd * 128, 1536, vt, sc, slope, qb * 256, od, 512, 0.f, nullptr, 1.f);
            attn_item<64, 2>(smem, bufD + (size_t)qb * 256 * 1536 + hd * 128 + 64, 1536, bufD + 512 + hd * 128 + 64, 1536, vt, sc, slope, qb * 256, od, 512, lam, a.in[31] + l * 128, 1.f - lam_init);
            continue; }
        r -= N_D;
        if (r < N_A) {
            const int qb = r & 7, hq = (r >> 3) & 7, b = r >> 6, hkv = hq >> 2;
            const bf16_t* bufA = (const bf16_t*)(wsl + OFF_BUFA) + (size_t)b * T * 1536;
            const bf16_t* vt = (const bf16_t*)(wsl + OFF_VTA) + ((size_t)b * 256 + hkv * 128) * T;
            bf16_t* oa = (bf16_t*)(wsl + OFF_OA) + ((size_t)b * T + qb * 256) * 1024 + hq * 128;
            attn_item<128, 0>(smem, bufA + (size_t)qb * 256 * 1536 + hq * 128, 1536, bufA + 1024 + hkv * 128, 1536, vt, 0.08838834764831845f * LOG2E, 0.f, qb * 256, oa, 1024, 0.f, nullptr, 1.f);
            continue; }
        r -= N_A;
        hyena_item(a, smem, l, r);
    }
}
__device__ __forceinline__ void post_phase(const Args& a, unsigned char* smem, int l) {
    unsigned char* wsl = launder_ws(a.ws); const int bid_ = lbid();
    const int tid = ltid();
    const bf16_t* bufB = (const bf16_t*)(wsl + OFF_BUFB);
    const float* yT = (const float*)(wsl + OFF_YT);
    bf16_t* ob = (bf16_t*)(wsl + OFF_OB);
    const float* cw = a.in[5] + (size_t)l * 3 * 1536; const float* cb = a.in[6] + (size_t)l * 1536; const float* skip = a.in[15] + l * 512;
    float* Y = (float*)smem;
    for (int it = bid_; it < 8 * 32 * 8; it += gridDim.x) {
        const int cb_ = it & 7, tb = (it >> 3) & 31, b = it >> 8;
        { const int cl = tid >> 3, tch = tid & 7; const float* yp = yT + ((size_t)(cb_ * 64 + cl) * 8 + b) * 2048 + tb * 64 + tch * 8;
          const f32x4 y0 = *(const f32x4*)yp, y1 = *(const f32x4*)(yp + 4); float* d = Y + cl * 65 + tch * 8;
          d[0] = y0[0]; d[1] = y0[1]; d[2] = y0[2]; d[3] = y0[3]; d[4] = y1[0]; d[5] = y1[1]; d[6] = y1[2]; d[7] = y1[3]; }
        __syncthreads();
        {
            const int tl = tid >> 3, c0 = cb_ * 64 + (tid & 7) * 8, t = tb * 64 + tl; const size_t tok = (size_t)b * T + t;
            float cv[3][8];
#pragma unroll
            for (int grp = 0; grp < 3; ++grp) { const int col = grp * 512 + c0;
                const u32x4 u1 = *(const u32x4*)(bufB + tok * 1536 + col);
                u32x4 u0 = {0u, 0u, 0u, 0u}, u2 = {0u, 0u, 0u, 0u};
                if (t > 0) u0 = *(const u32x4*)(bufB + (tok - 1) * 1536 + col);
                if (t < T - 1) u2 = *(const u32x4*)(bufB + (tok + 1) * 1536 + col);
                const f32x4 w0a = *(const f32x4*)(cw + col), w0b = *(const f32x4*)(cw + col + 4), w1a = *(const f32x4*)(cw + 1536 + col), w1b = *(const f32x4*)(cw + 1536 + col + 4);
                const f32x4 w2a = *(const f32x4*)(cw + 3072 + col), w2b = *(const f32x4*)(cw + 3072 + col + 4), ba = *(const f32x4*)(cb + col), bb = *(const f32x4*)(cb + col + 4);
                const unsigned p0[4] = {u0.x, u0.y, u0.z, u0.w}, p1[4] = {u1.x, u1.y, u1.z, u1.w}, p2[4] = {u2.x, u2.y, u2.z, u2.w};
#pragma unroll
                for (int j = 0; j < 4; ++j) { const float wl0 = j < 2 ? w0a[2 * j] : w0b[2 * j - 4], wh0 = j < 2 ? w0a[2 * j + 1] : w0b[2 * j - 3];
                    const float wl1 = j < 2 ? w1a[2 * j] : w1b[2 * j - 4], wh1 = j < 2 ? w1a[2 * j + 1] : w1b[2 * j - 3];
                    const float wl2 = j < 2 ? w2a[2 * j] : w2b[2 * j - 4], wh2 = j < 2 ? w2a[2 * j + 1] : w2b[2 * j - 3];
                    const float bl = j < 2 ? ba[2 * j] : bb[2 * j - 4], bh = j < 2 ? ba[2 * j + 1] : bb[2 * j - 3];
                    cv[grp][2 * j] = wl0 * bflo(p0[j]) + wl1 * bflo(p1[j]) + wl2 * bflo(p2[j]) + bl;
                    cv[grp][2 * j + 1] = wh0 * bfhi(p0[j]) + wh1 * bfhi(p1[j]) + wh2 * bfhi(p2[j]) + bh; } }
            const f32x4 ska = *(const f32x4*)(skip + c0), skb = *(const f32x4*)(skip + c0 + 4);
            float o8[8];
#pragma unroll
            for (int j = 0; j < 8; ++j) { const float z = cv[0][j] * cv[1][j], sk = j < 4 ? ska[j] : skb[j - 4];
                o8[j] = (Y[((tid & 7) * 8 + j) * 65 + tl] + z * sk) * cv[2][j]; }
            u32x4 w; w.x = pk2(o8[0], o8[1]); w.y = pk2(o8[2], o8[3]); w.z = pk2(o8[4], o8[5]); w.w = pk2(o8[6], o8[7]);
            *(u32x4*)(ob + tok * 512 + c0) = w; }
        __syncthreads();
    }
    const bf16_t* oc0 = (const bf16_t*)(wsl + OFF_OCDIR); const bf16_t* oc1 = oc0 + (size_t)M * 512; const bf16_t* gb = (const bf16_t*)(wsl + OFF_GBUF);
    bf16_t* ocv = (bf16_t*)(wsl + OFF_OC);
    for (size_t i = (size_t)bid_ * NTHR + tid; i < (size_t)M * 512 / 8; i += (size_t)gridDim.x * NTHR) {
        const u32x4 x0 = *(const u32x4*)(oc0 + i * 8), x1 = *(const u32x4*)(oc1 + i * 8), g = *(const u32x4*)(gb + i * 8); u32x4 o;
        o.x = pk2((bflo(x0.x) + bflo(x1.x)) * bflo(g.x), (bfhi(x0.x) + bfhi(x1.x)) * bfhi(g.x));
        o.y = pk2((bflo(x0.y) + bflo(x1.y)) * bflo(g.y), (bfhi(x0.y) + bfhi(x1.y)) * bfhi(g.y));
        o.z = pk2((bflo(x0.z) + bflo(x1.z)) * bflo(g.z), (bfhi(x0.z) + bfhi(x1.z)) * bfhi(g.z));
        o.w = pk2((bflo(x0.w) + bflo(x1.w)) * bflo(g.w), (bfhi(x0.w) + bfhi(x1.w)) * bfhi(g.w));
        *(u32x4*)(ocv + i * 8) = o; }
}

#if defined(DBG_STOP)
__device__ __forceinline__ void dbg_dump(const Args& a, const bf16_t* b0, size_t n0, const bf16_t* b1, size_t n1, const bf16_t* b2, size_t n2, const bf16_t* b3, size_t n3) {
    for (size_t i = (size_t)lbid() * NTHR + ltid(); i < (size_t)M * D; i += (size_t)gridDim.x * NTHR)
    {   float v0 = bf2f(b0[i % n0]), v1 = bf2f(b1[i % n1]), v2 = bf2f(b2[i % n2]), v3 = DBG_STOP == 41 ? ((const float*)b3)[i % (n3 / 2)] : bf2f(b3[i % n3]);
        const bool bad = !(fabsf(v0) < 1e30f) || !(fabsf(v1) < 1e30f) || !(fabsf(v2) < 1e30f) || !(fabsf(v3) < 1e30f);
        a.out[i] = bad ? 1e9f : (v0 + v1 + v2 + v3) * 1e-3f; }
}
#define DBG_AT(k, B0, N0, B1, N1, B2, N2, B3, N3) if (DBG_STOP == (k)) { dbg_dump(a, (const bf16_t*)(ws + (B0)), (size_t)(N0), (const bf16_t*)(ws + (B1)), (size_t)(N1), (const bf16_t*)(ws + (B2)), (size_t)(N2), (const bf16_t*)(ws + (B3)), (size_t)(N3)); }
#else
#define DBG_AT(k, B0, N0, B1, N1, B2, N2, B3, N3)
#endif
#define PHASE_SYNC() do { xcd_barrier(xb); ws = launder_ws(a.ws); hbuf = (bf16_t*)(ws + OFF_H); } while (0)
template <int L> __device__ __forceinline__ void run_layer(const Args& a, unsigned char* smem, const XcdBarrier& xb) {
    constexpr int l = L;
    unsigned char* ws = launder_ws(a.ws);
    bf16_t* hbuf = (bf16_t*)(ws + OFF_H);
        ws = launder_ws(a.ws); hbuf = (bf16_t*)(ws + OFF_H);
#if defined(DBG_DELAY)
        if (l == 1) { for (int i = 0; i < 20000; ++i) __builtin_amdgcn_s_sleep(64); PHASE_SYNC(); }
#endif
        for (int rep_ = 0; rep_ < (((PH_DUP >> 0) & 1) ? 2 : 1); ++rep_) if (((l + 1 < NLAYER) ? PH_MASK0 : PH_MASK) & (1 << 0)) {
        if (rep_ > 0) { PHASE_SYNC(); }
        if (lbid() == 0 && ltid() == 0) ((unsigned*)(ws + OFF_CTL))[64 * (1 + l)] = 0u;
        wconv_phase0(a, smem, l);
        if (l == 0) hid3_and_lam(a);
        rmsnorm_rows<true>(l == 0 ? a.in[0] : a.out, a.in[1] + l * 2048, hbuf, nullptr);
        }
        PHASE_SYNC();
        for (int rep_ = 0; rep_ < (((PH_DUP >> 1) & 1) ? 2 : 1); ++rep_) if (((l + 1 < NLAYER) ? PH_MASK0 : PH_MASK) & (1 << 1)) {
        if (rep_ > 0) { PHASE_SYNC(); }
        { EpiIn e; e.bA = (bf16_t*)(ws + OFF_BUFA); e.bB = (bf16_t*)(ws + OFF_BUFB); e.bD = (bf16_t*)(ws + OFF_BUFD); e.bC = (bf16_t*)(ws + OFF_BUFC);
          run_gemm(smem, hbuf, (const bf16_t*)(ws + OFF_WIN), DINP, 2048, e); }
        }
        PHASE_SYNC();
        for (int rep_ = 0; rep_ < (((PH_DUP >> 2) & 1) ? 2 : 1); ++rep_) if (((l + 1 < NLAYER) ? PH_MASK0 : PH_MASK) & (1 << 2)) {
        if (rep_ > 0) { PHASE_SYNC(); }
        prep_phase(a, smem, l);
        }
        PHASE_SYNC();
        for (int rep_ = 0; rep_ < (((PH_DUP >> 3) & 1) ? 2 : 1); ++rep_) if (((l + 1 < NLAYER) ? PH_MASK0 : PH_MASK) & (1 << 3)) {
        if (rep_ > 0) { PHASE_SYNC(); }
#pragma unroll 1
        for (int d = 0; d < 2; ++d) { EpiBf e; e.O = (bf16_t*)(ws + OFF_SLD) + (size_t)d * M * 1024; e.ldc = 1024; e.coff = 0;
            run_gemm(smem, (const bf16_t*)(ws + OFF_ALO) + (size_t)d * M * 256, (const bf16_t*)(ws + OFF_WLORA) + (size_t)d * 1024 * 256, 1024, 256, e); }
        { EpiBf e; e.O = (bf16_t*)(ws + OFF_GBUF); e.ldc = 512; e.coff = 0;
          run_gemm(smem, (const bf16_t*)(ws + OFF_AG), (const bf16_t*)(ws + OFF_WGUP), 512, 256, e); }
        }
        PHASE_SYNC();
        for (int rep_ = 0; rep_ < (((PH_DUP >> 4) & 1) ? 2 : 1); ++rep_) if (((l + 1 < NLAYER) ? PH_MASK0 : PH_MASK) & (1 << 4)) {
        if (rep_ > 0) { PHASE_SYNC(); }
        if (rep_ > 0) { if (lbid() == 0 && ltid() == 0) ((unsigned*)(ws + OFF_CTL))[64 * (1 + l)] = 0u; PHASE_SYNC(); }
        mixers_phase(a, smem, l);
        }
        PHASE_SYNC();
        for (int rep_ = 0; rep_ < (((PH_DUP >> 5) & 1) ? 2 : 1); ++rep_) if (((l + 1 < NLAYER) ? PH_MASK0 : PH_MASK) & (1 << 5)) {
        if (rep_ > 0) { PHASE_SYNC(); }
        post_phase(a, smem, l);
        }
        PHASE_SYNC();
        for (int rep_ = 0; rep_ < (((PH_DUP >> 6) & 1) ? 2 : 1); ++rep_) if (((l + 1 < NLAYER) ? PH_MASK0 : PH_MASK) & (1 << 6)) {
        if (rep_ > 0) { PHASE_SYNC(); }
#pragma unroll 1
        for (int g = 0; g < 4; ++g) { EpiBf e; e.O = (bf16_t*)(ws + OFF_P); e.ldc = 8192; e.coff = g * 2048;
            const bf16_t* A = g == 0 ? (const bf16_t*)(ws + OFF_OA) : (g == 1 ? (const bf16_t*)(ws + OFF_OB) : (g == 2 ? (const bf16_t*)(ws + OFF_OC) : (const bf16_t*)(ws + OFF_OD)));
            const bf16_t* Bt = (const bf16_t*)(ws + OFF_WBR) + (g == 0 ? (size_t)0 : (size_t)2048 * 1024 + (size_t)(g - 1) * 2048 * 512);
            run_gemm(smem, A, Bt, 2048, g == 0 ? 1024 : 512, e); }
        }
        PHASE_SYNC();
        for (int rep_ = 0; rep_ < (((PH_DUP >> 7) & 1) ? 2 : 1); ++rep_) if (((l + 1 < NLAYER) ? PH_MASK0 : PH_MASK) & (1 << 7)) {
        if (rep_ > 0) { PHASE_SYNC(); }
        { EpiGate e; e.P = (const bf16_t*)(ws + OFF_P); e.Mg = (bf16_t*)(ws + OFF_MERGED);
          run_gemm(smem, hbuf, (const bf16_t*)(ws + OFF_WG), 8192, 2048, e); }
        }
        PHASE_SYNC();
        for (int rep_ = 0; rep_ < (((PH_DUP >> 8) & 1) ? 2 : 1); ++rep_) if (((l + 1 < NLAYER) ? PH_MASK0 : PH_MASK) & (1 << 8)) {
        if (rep_ > 0) { PHASE_SYNC(); }
        { EpiRes e; e.base = l == 0 ? a.in[0] : a.out; e.out = a.out;
          run_gemm(smem, (const bf16_t*)(ws + OFF_MERGED), (const bf16_t*)(ws + OFF_WO), 2048, 2048, e); }
        }
        PHASE_SYNC();
        for (int rep_ = 0; rep_ < (((PH_DUP >> 9) & 1) ? 2 : 1); ++rep_) if (((l + 1 < NLAYER) ? PH_MASK0 : PH_MASK) & (1 << 9)) {
        if (rep_ > 0) { PHASE_SYNC(); }
        rmsnorm_rows<true>(a.out, a.in[35] + l * 2048, hbuf, nullptr);
        }
        PHASE_SYNC();
        for (int rep_ = 0; rep_ < (((PH_DUP >> 10) & 1) ? 2 : 1); ++rep_) if (((l + 1 < NLAYER) ? PH_MASK0 : PH_MASK) & (1 << 10)) {
        if (rep_ > 0) { PHASE_SYNC(); }
        { EpiFfn e; e.act = (bf16_t*)(ws + OFF_ACT);
          run_gemm(smem, hbuf, (const bf16_t*)(ws + OFF_WFF), 11264, 2048, e); }
        }
        PHASE_SYNC();
        for (int rep_ = 0; rep_ < (((PH_DUP >> 11) & 1) ? 2 : 1); ++rep_) if (((l + 1 < NLAYER) ? PH_MASK0 : PH_MASK) & (1 << 11)) {
        if (rep_ > 0) { PHASE_SYNC(); }
        { EpiRes e; e.base = a.out; e.out = a.out;
          run_gemm(smem, (const bf16_t*)(ws + OFF_ACT), (const bf16_t*)(ws + OFF_WD), 2048, FFN, e); }
        }
        PHASE_SYNC();
}
__global__ void __launch_bounds__(NTHR) hybrid_encoder_fwd(Args a) {
    unsigned char* smem = g_smem;
    cg::grid_group grid = cg::this_grid();
    unsigned char* ws = launder_ws(a.ws);
    bf16_t* hbuf = (bf16_t*)(ws + OFF_H);
#if defined(WS_FILL)
    { u32x4* p = (u32x4*)(ws + 8192); const size_t n = (WS_END - 8192) / 16; const u32x4 v = {WS_FILL, WS_FILL, WS_FILL, WS_FILL};
      for (size_t i = (size_t)lbid() * NTHR + ltid(); i < n; i += (size_t)gridDim.x * NTHR) p[i] = v; }
    PHASE_SYNC();
#endif
    unsigned* xbar = (unsigned*)(launder_ws(a.ws) + OFF_XBAR);
    volatile XLAS unsigned* xst = (volatile XLAS unsigned*)(g_smem + LDS_BYTES - 64);
    if (ltid() == 0) { xst[0] = 0u; xst[1] = 0u; xst[2] = 0u; xst[3] = 0u; }
    if (lbid() == 0) { for (int i = ltid(); i < XCD_BAR_WORDS; i += NTHR) __hip_atomic_store(xbar + i, 0u, __ATOMIC_RELAXED, __HIP_MEMORY_SCOPE_AGENT); }
    asm volatile("s_waitcnt vmcnt(0) lgkmcnt(0)" ::: "memory"); __builtin_amdgcn_fence(__ATOMIC_RELEASE, "agent"); asm volatile("s_waitcnt vmcnt(0)" ::: "memory"); __syncthreads();
    grid.sync();
    __builtin_amdgcn_fence(__ATOMIC_ACQUIRE, "agent"); asm volatile("s_waitcnt vmcnt(0)" ::: "memory"); __syncthreads();
    const XcdBarrier xb = xcd_barrier_post(xbar, xst);
    run_layer<0>(a, smem, xb);
    if (NLAYER > 1) run_layer<1>(a, smem, xb);
#if defined(DBG_STOP)
    DBG_AT(0, OFF_H, M*2048, OFF_WIN, DINP*2048, OFF_WG, 8192*2048, OFF_WBR, 2048*2560)
    DBG_AT(1, OFF_BUFA, M*1536, OFF_BUFB, M*1536, OFF_BUFD, M*1536, OFF_BUFC, M*2048)
    DBG_AT(2, OFF_BUFA, M*1536, OFF_ALO, 3*M*256, OFF_ZT, 512*8*2048, OFF_VTA, 3*8*256*2048)
    DBG_AT(3, OFF_SLD, 2*M*512, OFF_SA, 2*M*512, OFF_GBUF, M*512, OFF_GBUF, M*512)
    DBG_AT(4, OFF_OA, M*1024, OFF_OD, M*512, OFF_OCDIR, 2*M*512, OFF_YT, 2*512*8*2048)
    DBG_AT(40, OFF_OA, M*1024, OFF_OA, M*1024, OFF_OD, M*512, OFF_OD, M*512)
    DBG_AT(41, OFF_OCDIR, 2*M*512, OFF_OCDIR, 2*M*512, OFF_OCDIR, 2*M*512, OFF_YT, 2*512*8*2048)
    DBG_AT(42, OFF_OA, M*1024, OFF_OA, M*1024, OFF_OA, M*1024, OFF_OA, M*1024)
    DBG_AT(43, OFF_OCDIR, 2*M*512, OFF_OCDIR, 2*M*512, OFF_OCDIR, 2*M*512, OFF_OCDIR, 2*M*512)
    DBG_AT(5, OFF_OB, M*512, OFF_OC, M*512, OFF_OB, M*512, OFF_OC, M*512)
    DBG_AT(6, OFF_P, M*8192, OFF_P, M*8192, OFF_P, M*8192, OFF_P, M*8192)
    DBG_AT(7, OFF_MERGED, M*2048, OFF_MERGED, M*2048, OFF_MERGED, M*2048, OFF_MERGED, M*2048)
    if (DBG_STOP == 11) { for (size_t i = (size_t)lbid() * NTHR + ltid(); i < (size_t)M * D; i += (size_t)gridDim.x * NTHR) { const float v = a.out[i]; a.out[i] = (fabsf(v) < 1e30f) ? v : 1e9f; } }
#else
    rmsnorm_rows<false>(a.out, a.in[39], nullptr, a.out);
#endif
}

extern "C" void kernel_launch(void* const* d_in, const int* in_sizes, int n_in, void* d_out, int out_size, void* d_ws, size_t ws_size, hipStream_t stream) {
    static int grid = 0;
    if (grid == 0) {
        if (n_in != 40 || out_size != M * D || ws_size < WS_END) { fprintf(stderr, "kernel_launch: unexpected shapes (n_in %d out %d ws %zu need %zu)\n", n_in, out_size, ws_size, (size_t)WS_END); grid = -1; return; }
        int dev = 0, cus = 0;
        hipGetDevice(&dev); hipDeviceGetAttribute(&cus, hipDeviceAttributeMultiprocessorCount, dev);
        if (hipFuncSetAttribute((const void*)hybrid_encoder_fwd, hipFuncAttributeMaxDynamicSharedMemorySize, LDS_BYTES) != hipSuccess) { fprintf(stderr, "kernel_launch: hipFuncSetAttribute failed\n"); grid = -1; return; }
        int per_cu = 0;
        hipOccupancyMaxActiveBlocksPerMultiprocessor(&per_cu, (const void*)hybrid_encoder_fwd, NTHR, LDS_BYTES);
        (void)hipGetLastError();
        grid = cus > 0 ? cus : 256;
    }
    if (grid < 0) return;
    Args a{};
    for (int i = 0; i < 40; ++i) a.in[i] = (const float*)d_in[i];
    a.out = (float*)d_out; a.ws = (unsigned char*)d_ws;
    void* args[] = {&a};
    hipError_t e = hipLaunchCooperativeKernel((const void*)hybrid_encoder_fwd, dim3(grid), dim3(NTHR), args, LDS_BYTES, stream);
    if (e != hipSuccess) fprintf(stderr, "cooperative launch failed: %s (grid %d)\n", hipGetErrorString(e), grid);
}
```
